# Optimizing an MI355X kernel written in HIP

```python
import jax, jax.numpy as jnp
from jax import lax
import numpy as np

D_MODEL = 1024
BATCH = 16
SEQ = 2048
DEPTH = 2

MEM_LEN = 256
RET_HEADS = 4
RET_DK = 64
RET_DV = 128
RET_CHUNK = 128
GLA_HEADS = 4
GLA_DK = 64
GLA_DV = 128
GLA_CHUNK = 64
GLA_GATE_RANK = 16
GLA_GATE_TAU = 16.0
XA_HEADS = 4
XA_DH = D_MODEL // XA_HEADS
D_FF = 2816
ROPE_BASE = 10000.0
EPS = 1e-6

RET_W = RET_HEADS * RET_DV
GLA_W = GLA_HEADS * GLA_DV
MIX_W = RET_W + GLA_W
IN_SIZES = (
    RET_HEADS * RET_DK,
    RET_HEADS * RET_DK,
    RET_W,
    RET_W,
    GLA_HEADS * GLA_DK,
    GLA_HEADS * GLA_DK,
    GLA_W,
    GLA_GATE_RANK,
    GLA_W,
)
IN_DIM = sum(IN_SIZES)

kernel_name = "hybrid_retention_gla_macaron_block"


def _split_points():
    pts, acc = [], 0
    for s in IN_SIZES[:-1]:
        acc += s
        pts.append(acc)
    return pts


def rmsnorm(x, g):
    xf = x.astype(jnp.float32)
    y = xf * lax.rsqrt(jnp.mean(xf * xf, axis=-1, keepdims=True) + EPS)
    return (y * g.astype(jnp.float32)).astype(x.dtype)


def swiglu(h, w_gate, w_up, w_down):
    return (jax.nn.silu(h @ w_gate) * (h @ w_up)) @ w_down


def rope(x, cos, sin):
    half = x.shape[-1] // 2
    x1, x2 = x[..., :half], x[..., half:]
    c, s = cos.astype(x.dtype), sin.astype(x.dtype)
    return jnp.concatenate([x1 * c - x2 * s, x1 * s + x2 * c], axis=-1)


def to_chunks(x, c):
    b, t, h, d = x.shape
    return x.reshape(b, t // c, c, h, d).transpose(1, 0, 3, 2, 4)


def from_chunks(o):
    n, b, h, c, d = o.shape
    return o.transpose(1, 0, 3, 2, 4).reshape(b, n * c, h, d)


def retention(q, k, v):
    b, t, h, dk = q.shape
    dv = v.shape[-1]
    c = RET_CHUNK
    log_gamma = jnp.log1p(-jnp.exp2(-5.0 - jnp.arange(h, dtype=jnp.float32)))
    idx = jnp.arange(c, dtype=jnp.float32)
    rel = idx[:, None] - idx[None, :]
    causal = rel >= 0
    decay_in = jnp.where(causal[None], jnp.exp(jnp.where(causal, rel, 0.0)[None] * log_gamma[:, None, None]), 0.0)
    q_dec = jnp.exp((idx + 1.0)[None, :] * log_gamma[:, None])
    k_dec = jnp.exp((c - 1.0 - idx)[None, :] * log_gamma[:, None])
    chunk_dec = jnp.exp(c * log_gamma)

    def step(state, inp):
        qc, kc, vc = inp
        scores = jnp.einsum('bhid,bhjd->bhij', qc, kc) * decay_in[None]
        o = (jnp.einsum('bhij,bhjv->bhiv', scores, vc)
             + jnp.einsum('bhid,bhdv->bhiv', qc * q_dec[None, :, :, None], state))
        state = (chunk_dec[None, :, None, None] * state
                 + jnp.einsum('bhjd,bhjv->bhdv', kc * k_dec[None, :, :, None], vc))
        return state, o

    s0 = jnp.zeros((b, h, dk, dv), jnp.float32)
    _, o = lax.scan(step, s0, (to_chunks(q, c), to_chunks(k, c), to_chunks(v, c)))
    return from_chunks(o)


def gla(q, k, v, log_a):
    b, t, h, dk = q.shape
    dv = v.shape[-1]
    c = GLA_CHUNK
    mask = jnp.tril(jnp.ones((c, c), dtype=bool))[:, :, None]

    def step(state, inp):
        qc, kc, vc, gc = inp
        cum = jnp.cumsum(gc, axis=-2)
        diff = cum[:, :, :, None, :] - cum[:, :, None, :, :]
        decay = jnp.exp(jnp.where(mask, diff, -jnp.inf))
        scores = jnp.einsum('bhid,bhjd,bhijd->bhij', qc, kc, decay)
        o = (jnp.einsum('bhij,bhjv->bhiv', scores, vc)
             + jnp.einsum('bhid,bhdv->bhiv', qc * jnp.exp(cum), state))
        last = cum[:, :, -1:, :]
        state = (jnp.exp(last[:, :, 0, :])[..., None] * state
                 + jnp.einsum('bhjd,bhjv->bhdv', kc * jnp.exp(last - cum), vc))
        return state, o

    s0 = jnp.zeros((b, h, dk, dv), jnp.float32)
    _, o = lax.scan(step, s0, (to_chunks(q, c), to_chunks(k, c), to_chunks(v, c), to_chunks(log_a, c)))
    return from_chunks(o)


def hybrid_mixer(h, cos, sin, w_in, w_a2, b_a2, ret_norm_g, gla_norm_g, w_out):
    bsz, t, _ = h.shape
    z = h @ w_in
    rq, rk, rv, rg, gq, gk, gv, ga, gg = jnp.split(z, _split_points(), axis=-1)
    rq = rope(rq.reshape(bsz, t, RET_HEADS, RET_DK), cos, sin)
    rk = rope(rk.reshape(bsz, t, RET_HEADS, RET_DK), cos, sin) * (RET_DK ** -0.5)
    ro = retention(rq, rk, rv.reshape(bsz, t, RET_HEADS, RET_DV))
    ro = rmsnorm(ro, ret_norm_g).astype(h.dtype).reshape(bsz, t, RET_W) * jax.nn.silu(rg)
    log_a = jax.nn.log_sigmoid((ga @ w_a2 + b_a2).astype(jnp.float32)) / GLA_GATE_TAU
    log_a = log_a.reshape(bsz, t, GLA_HEADS, GLA_DK)
    go = gla(gq.reshape(bsz, t, GLA_HEADS, GLA_DK) * (GLA_DK ** -0.5),
             gk.reshape(bsz, t, GLA_HEADS, GLA_DK),
             gv.reshape(bsz, t, GLA_HEADS, GLA_DV), log_a)
    go = rmsnorm(go, gla_norm_g).astype(h.dtype).reshape(bsz, t, GLA_W) * jax.nn.silu(gg)
    return jnp.concatenate([ro, go], axis=-1) @ w_out


def memory_cross_attn(h, mem_n, w_q, w_kv, w_o):
    bsz, t, _ = h.shape
    m = mem_n.shape[1]
    q = (h @ w_q).reshape(bsz, t, XA_HEADS, XA_DH)
    k, v = jnp.split(mem_n @ w_kv, 2, axis=-1)
    k = k.reshape(bsz, m, XA_HEADS, XA_DH)
    v = v.reshape(bsz, m, XA_HEADS, XA_DH)
    s = jnp.einsum('bthd,bmhd->bhtm', q, k).astype(jnp.float32) * (XA_DH ** -0.5)
    p = jax.nn.softmax(s, axis=-1).astype(v.dtype)
    o = jnp.einsum('bhtm,bmhd->bthd', p, v).reshape(bsz, t, D_MODEL)
    return o @ w_o


def setup_inputs(seed: int = 0) -> dict:
    key = jax.random.key(seed)
    ks = iter(jax.random.split(key, 40))
    f32 = jnp.float32

    def w(shape, fan_in):
        return jax.random.normal(next(ks), (DEPTH,) + shape, f32) * (fan_in ** -0.5)

    def gain(shape):
        return 1.0 + 0.02 * jax.random.normal(next(ks), (DEPTH,) + shape, f32)

    x = jax.random.normal(next(ks), (BATCH, SEQ, D_MODEL), f32)
    mem = jax.random.normal(next(ks), (BATCH, MEM_LEN, D_MODEL), f32)
    offset = jax.random.randint(next(ks), (BATCH, 1), 0, 4096, dtype=jnp.int32)
    positions = offset + jnp.arange(SEQ, dtype=jnp.int32)[None, :]
    return {
        "x": x, "mem": mem, "positions": positions,
        "ffn1_pre_g": gain((D_MODEL,)),
        "ffn1_w_gate": w((D_MODEL, D_FF), D_MODEL),
        "ffn1_w_up": w((D_MODEL, D_FF), D_MODEL),
        "ffn1_w_down": w((D_FF, D_MODEL), D_FF),
        "ffn1_post_g": gain((D_MODEL,)),
        "mix_pre_g": gain((D_MODEL,)),
        "w_in": w((D_MODEL, IN_DIM), D_MODEL),
        "w_a2": w((GLA_GATE_RANK, GLA_HEADS * GLA_DK), GLA_GATE_RANK),
        "b_a2": 0.01 * jax.random.normal(next(ks), (DEPTH, GLA_HEADS * GLA_DK), f32),
        "ret_norm_g": gain((RET_HEADS, RET_DV)),
        "gla_norm_g": gain((GLA_HEADS, GLA_DV)),
        "w_out": w((MIX_W, D_MODEL), MIX_W),
        "mix_post_g": gain((D_MODEL,)),
        "xa_pre_g": gain((D_MODEL,)),
        "xa_mem_g": gain((D_MODEL,)),
        "xa_w_q": w((D_MODEL, D_MODEL), D_MODEL),
        "xa_w_kv": w((D_MODEL, 2 * D_MODEL), D_MODEL),
        "xa_w_o": w((D_MODEL, D_MODEL), D_MODEL),
        "xa_post_g": gain((D_MODEL,)),
        "ffn2_pre_g": gain((D_MODEL,)),
        "ffn2_w_gate": w((D_MODEL, D_FF), D_MODEL),
        "ffn2_w_up": w((D_MODEL, D_FF), D_MODEL),
        "ffn2_w_down": w((D_FF, D_MODEL), D_FF),
        "ffn2_post_g": gain((D_MODEL,)),
    }


def reference(x, mem, positions,
              ffn1_pre_g, ffn1_w_gate, ffn1_w_up, ffn1_w_down, ffn1_post_g,
              mix_pre_g, w_in, w_a2, b_a2, ret_norm_g, gla_norm_g, w_out, mix_post_g,
              xa_pre_g, xa_mem_g, xa_w_q, xa_w_kv, xa_w_o, xa_post_g,
              ffn2_pre_g, ffn2_w_gate, ffn2_w_up, ffn2_w_down, ffn2_post_g):
    inv_freq = ROPE_BASE ** (-jnp.arange(0, RET_DK, 2, dtype=jnp.float32) / RET_DK)
    ang = positions.astype(jnp.float32)[..., None] * inv_freq
    cos = jnp.cos(ang)[:, :, None, :]
    sin = jnp.sin(ang)[:, :, None, :]

    for l in range(DEPTH):
        x = x + 0.5 * rmsnorm(swiglu(rmsnorm(x, ffn1_pre_g[l]), ffn1_w_gate[l], ffn1_w_up[l], ffn1_w_down[l]), ffn1_post_g[l])
        x = x + rmsnorm(hybrid_mixer(rmsnorm(x, mix_pre_g[l]), cos, sin, w_in[l], w_a2[l], b_a2[l],
                                     ret_norm_g[l], gla_norm_g[l], w_out[l]), mix_post_g[l])
        x = x + rmsnorm(memory_cross_attn(rmsnorm(x, xa_pre_g[l]), rmsnorm(mem, xa_mem_g[l]),
                                          xa_w_q[l], xa_w_kv[l], xa_w_o[l]), xa_post_g[l])
        x = x + 0.5 * rmsnorm(swiglu(rmsnorm(x, ffn2_pre_g[l]), ffn2_w_gate[l], ffn2_w_up[l], ffn2_w_down[l]), ffn2_post_g[l])
    return x
```

```cpp
#include <hip/hip_runtime.h>
#include <cstdio>
#include <cstdint>
#ifndef MK_ONE_LAUNCH
#define MK_ONE_LAUNCH 0
#endif
namespace pg8 {
#define PG8_LAS __attribute__((address_space(3)))
typedef unsigned short bf16_t;
typedef short bf16x8 __attribute__((ext_vector_type(8)));
typedef float f32x4 __attribute__((ext_vector_type(4)));
typedef unsigned u32x4 __attribute__((ext_vector_type(4)));
constexpr int BM = 256, BK = 64, HALF = 128, HTB = HALF * BK * 2  , STAGE_BYTES = 8 * HTB, NXCD = 8, WGM = 8;

__host__ __device__ __forceinline__ int lds_byte(int r, int c) { const int st = (r >> 4) * 2 + (c >> 5), rr = r & 15, cc = c & 31, ob = rr * 64 + cc * 2; return st * 1024 + (ob ^ (((ob >> 9) & 1) << 5)); }
__host__ __device__ __forceinline__ void stage_rc(int b, int& R, int& C) { const int st = b / 1024, sb = b % 1024, swz = sb ^ (((sb >> 9) & 1) << 5); R = (st >> 1) * 16 + swz / 64; C = (st & 1) * 32 + (swz % 64) / 2; }
__host__ __device__ __forceinline__ int perm32(int rho) { const int n = rho >> 4, i = rho & 15; return 8 * (i >> 2) + 4 * n + (i & 3); }

struct Unit { int pm, pn; };
struct Gemm { const bf16_t* A; const bf16_t* Bt; int M, N, K; };

struct StaticOrder {
    int nM, nN, nwg, G, c;
    __host__ __device__ void init(int M, int N, int G_, int c_) { nM = M / BM; nN = N / BM; nwg = nM * nN; G = G_; c = c_; }
    __host__ __device__ bool next(int i, Unit& u) const {
        const long L = (long)i * G + c; if (L >= nwg) return false;
        int wgid = (int)L; { const int q = nwg / NXCD, r = nwg % NXCD, xcd = wgid % NXCD, off = wgid / NXCD; wgid = (xcd < r ? xcd * (q + 1) : r * (q + 1) + (xcd - r) * q) + off; }
        const int nig = WGM * nN, gid = wgid / nig, fm = gid * WGM, gsz = (nM - fm) < WGM ? (nM - fm) : WGM;
        u.pm = fm + ((wgid % nig) % gsz); u.pn = (wgid % nig) / gsz; return true;
    }
    __device__ __forceinline__ void a_ready(const Unit&) const {}
    __device__ __forceinline__ void done(const Unit&) const {}
};

__device__ __forceinline__ unsigned cvt_pk_bf16(float lo, float hi) { unsigned r; asm volatile("v_cvt_pk_bf16_f32 %0, %1, %2" : "=v"(r) : "v"(lo), "v"(hi)); return r; }
constexpr float RMS_EPS = 1e-6f;
typedef unsigned u32x2 __attribute__((ext_vector_type(2)));
__device__ __forceinline__ float sigmoid_f(float x) { return __builtin_amdgcn_rcpf(1.0f + __expf(-x)); }
__device__ __forceinline__ f32x4 silu4(f32x4 v) { f32x4 o; o[0] = v[0] * sigmoid_f(v[0]); o[1] = v[1] * sigmoid_f(v[1]); o[2] = v[2] * sigmoid_f(v[2]); o[3] = v[3] * sigmoid_f(v[3]); return o; }
__device__ __forceinline__ u32x4 pack8(f32x4 v0, f32x4 v1) { u32x4 w; w.x = cvt_pk_bf16(v0[0], v0[1]); w.y = cvt_pk_bf16(v0[2], v0[3]); w.z = cvt_pk_bf16(v1[0], v1[1]); w.w = cvt_pk_bf16(v1[2], v1[3]); return w; }

struct EpiPlain {
    static constexpr bool PERM = true, AFTER_DRAIN = false;
    bf16_t* O; int ldc;
    __device__ __forceinline__ void operator()(const f32x4 (&acc)[2][2][4][2], const Unit& u, int wr, int wc, int fr, int fq) const {
        const int row0 = u.pm * BM + wr * 64 + fr, col0 = u.pn * BM + wc * 32 + 8 * fq;
#pragma unroll
        for (int ai = 0; ai < 2; ++ai)
#pragma unroll
            for (int m = 0; m < 4; ++m) { bf16_t* rowp = O + (size_t)(row0 + ai * HALF + m * 16) * ldc + col0;
#pragma unroll
                for (int bj = 0; bj < 2; ++bj) *(u32x4*)(rowp + bj * HALF) = pack8(acc[ai][bj][m][0], acc[ai][bj][m][1]); }
    }
};
struct EpiRowScale {
    static constexpr bool PERM = true, AFTER_DRAIN = false;
    bf16_t* O; int ldc; const float* rs;
    __device__ __forceinline__ void operator()(const f32x4 (&acc)[2][2][4][2], const Unit& u, int wr, int wc, int fr, int fq) const {
        const int row0 = u.pm * BM + wr * 64 + fr, col0 = u.pn * BM + wc * 32 + 8 * fq;
#pragma unroll
        for (int ai = 0; ai < 2; ++ai)
#pragma unroll
            for (int m = 0; m < 4; ++m) { const int row = row0 + ai * HALF + m * 16; const float r = rs[row]; bf16_t* rowp = O + (size_t)row * ldc + col0;
#pragma unroll
                for (int bj = 0; bj < 2; ++bj) *(u32x4*)(rowp + bj * HALF) = pack8(acc[ai][bj][m][0] * r, acc[ai][bj][m][1] * r); }
    }
};
struct EpiColScale {
    static constexpr bool PERM = true, AFTER_DRAIN = false;
    bf16_t* O; int ldc; const float* cs;
    __device__ __forceinline__ void operator()(const f32x4 (&acc)[2][2][4][2], const Unit& u, int wr, int wc, int fr, int fq) const {
        const int row0 = u.pm * BM + wr * 64 + fr, col0 = u.pn * BM + wc * 32 + 8 * fq;
        f32x4 s[2][2];
#pragma unroll
        for (int bj = 0; bj < 2; ++bj) { s[bj][0] = *(const f32x4*)(cs + col0 + bj * HALF); s[bj][1] = *(const f32x4*)(cs + col0 + bj * HALF + 4); }
#pragma unroll
        for (int ai = 0; ai < 2; ++ai)
#pragma unroll
            for (int m = 0; m < 4; ++m) { bf16_t* rowp = O + (size_t)(row0 + ai * HALF + m * 16) * ldc + col0;
#pragma unroll
                for (int bj = 0; bj < 2; ++bj) *(u32x4*)(rowp + bj * HALF) = pack8(acc[ai][bj][m][0] * s[bj][0], acc[ai][bj][m][1] * s[bj][1]); }
    }
};
struct EpiGU {
    static constexpr bool PERM = true, AFTER_DRAIN = false;
    bf16_t* H; int ldh; const float* rs;
    __device__ __forceinline__ void operator()(const f32x4 (&acc)[2][2][4][2], const Unit& u, int wr, int wc, int fr, int fq) const {
        const int row0 = u.pm * BM + wr * 64 + fr, col0 = u.pn * HALF + wc * 32 + 8 * fq;
#pragma unroll
        for (int ai = 0; ai < 2; ++ai)
#pragma unroll
            for (int m = 0; m < 4; ++m) { const int row = row0 + ai * HALF + m * 16; const float r = rs[row];
                const f32x4 h0 = silu4(acc[ai][0][m][0] * r) * (acc[ai][1][m][0] * r), h1 = silu4(acc[ai][0][m][1] * r) * (acc[ai][1][m][1] * r);
                *(u32x4*)(H + (size_t)row * ldh + col0) = pack8(h0, h1); }
    }
};
struct EpiWin {
    static constexpr bool PERM = true, AFTER_DRAIN = false;
    bf16_t* Z; float* LA; const float* rs; const float* cosT; const float* sinT; const float* ba2;
    __device__ __forceinline__ void operator()(const f32x4 (&acc)[2][2][4][2], const Unit& u, int wr, int wc, int fr, int fq) const {
        const int row0 = u.pm * BM + wr * 64 + fr, cin = wc * 32 + 8 * fq, pn = u.pn;
        if (pn <= 1) {
            const int f0 = 16 * (wc & 1) + 4 * fq;
#pragma unroll
            for (int ai = 0; ai < 2; ++ai)
#pragma unroll
                for (int m = 0; m < 4; ++m) { const int row = row0 + ai * HALF + m * 16; const float r = rs[row];
                    const f32x4 c4 = *(const f32x4*)(cosT + (size_t)row * 32 + f0), s4 = *(const f32x4*)(sinT + (size_t)row * 32 + f0);
                    bf16_t* rowp = Z + (size_t)row * 3072 + pn * BM + cin;
#pragma unroll
                    for (int bj = 0; bj < 2; ++bj) { const f32x4 x1 = acc[ai][bj][m][0] * r, x2 = acc[ai][bj][m][1] * r;
                        *(u32x4*)(rowp + bj * HALF) = pack8(x1 * c4 - x2 * s4, x1 * s4 + x2 * c4); } }
        } else if (pn == 12) {
#pragma unroll
            for (int ai = 0; ai < 2; ++ai)
#pragma unroll
                for (int m = 0; m < 4; ++m) { const int row = row0 + ai * HALF + m * 16; const float r = rs[row];
#pragma unroll
                    for (int bj = 0; bj < 2; ++bj)
#pragma unroll
                        for (int n = 0; n < 2; ++n) { const int col = bj * HALF + cin + 4 * n; const f32x4 x = acc[ai][bj][m][n] * r + *(const f32x4*)(ba2 + col); f32x4 o;
#pragma unroll
                            for (int i = 0; i < 4; ++i) o[i] = (fminf(x[i], 0.f) - __logf(1.0f + __expf(-fabsf(x[i])))) * 0.0625f;
                            *(f32x4*)(LA + (size_t)row * 256 + col) = o; } }
        } else {
            const bool act = (pn == 4) | (pn == 5) | (pn == 10) | (pn == 11);
#pragma unroll
            for (int ai = 0; ai < 2; ++ai)
#pragma unroll
                for (int m = 0; m < 4; ++m) { const int row = row0 + ai * HALF + m * 16; const float r = rs[row]; bf16_t* rowp = Z + (size_t)row * 3072 + pn * BM + cin;
#pragma unroll
                    for (int bj = 0; bj < 2; ++bj) { f32x4 v0 = acc[ai][bj][m][0] * r, v1 = acc[ai][bj][m][1] * r; if (act) { v0 = silu4(v0); v1 = silu4(v1); }
                        *(u32x4*)(rowp + bj * HALF) = pack8(v0, v1); } }
        }
    }
};
template <class Epi, class Sched, bool ALIGN_EPI = false, bool SP2 = false>
__device__ __forceinline__ void gemm_phase(PG8_LAS unsigned char* lds, const Gemm g, const Sched& S, const Epi& E) {
    int tid_ = threadIdx.x; asm volatile("" : "+v"(tid_));
    const int tid = tid_, wid = __builtin_amdgcn_readfirstlane(tid >> 6), lane = tid & 63, wr = wid >> 2, wc = wid & 3, fr = lane & 15, fq = lane >> 4;
    const int K = g.K, nt = K / BK;
    unsigned voffA[2], voffB[2];
#pragma unroll
    for (int i = 0; i < 2; ++i) { int R, C; stage_rc(tid * 16 + i * 8192, R, C); const int Rb = Epi::PERM ? ((R & ~31) + perm32(R & 31)) : R;
        voffA[i] = (unsigned)(R * K + C) * 2u; voffB[i] = (unsigned)(Rb * K + C) * 2u; }
    const size_t kstep = (size_t)(BK * 2);
    const size_t hstep = (size_t)HALF * K * 2;
    const size_t tstep = 2 * hstep;
    const unsigned ldsw = (unsigned)wid * 1024u;
    const int aoff = lds_byte(wr * 64 + fr, fq * 8), boff = lds_byte(wc * 32 + fr, fq * 8);
#define PG8_SA(b, h) (((b) * 2 + (h)) * HTB)
#define PG8_SB(b, h) ((4 + (b) * 2 + (h)) * HTB)
#define PG8_STAGE(bufoff, gbase, voff) do { _Pragma("unroll") for (int _i = 0; _i < 2; ++_i) \
        __builtin_amdgcn_global_load_lds((const unsigned*)((const char*)(gbase) + (voff)[_i]), (PG8_LAS unsigned*)(lds + (bufoff) + ldsw + _i * 8192), 16, 0, 0); } while (0)
#define PG8_LDA(dst, b, h) do { _Pragma("unroll") for (int m = 0; m < 4; ++m) _Pragma("unroll") for (int k = 0; k < 2; ++k) dst[m][k] = *(const PG8_LAS bf16x8*)(lds + PG8_SA(b, h) + aoff + m * 2048 + k * 1024); } while (0)
#define PG8_LDB(dst, b, h) do { _Pragma("unroll") for (int n = 0; n < 2; ++n) _Pragma("unroll") for (int k = 0; k < 2; ++k) dst[n][k] = *(const PG8_LAS bf16x8*)(lds + PG8_SB(b, h) + boff + n * 2048 + k * 1024); } while (0)
#define PG8_MMA(ai, bj, At, Bt) do { __builtin_amdgcn_s_setprio(1); _Pragma("unroll") for (int m = 0; m < 4; ++m) _Pragma("unroll") for (int n = 0; n < 2; ++n) _Pragma("unroll") for (int k = 0; k < 2; ++k) \
        acc[ai][bj][m][n] = __builtin_amdgcn_mfma_f32_16x16x32_bf16(Bt[n][k], At[m][k], acc[ai][bj][m][n], 0, 0, 0); __builtin_amdgcn_s_setprio(0); } while (0)
#define PG8_WAIT_V(n) asm volatile("s_waitcnt vmcnt(" #n ")" ::: "memory")
#define PG8_WAIT_L(n) asm volatile("s_waitcnt lgkmcnt(" #n ")" ::: "memory")
#define PG8_BAR __builtin_amdgcn_s_barrier()
#define PG8_SCHED __builtin_amdgcn_sched_barrier(0)
    Unit cur, nxt; int ui = 0;
    if (!S.next(0, cur)) return;
    f32x4 acc[2][2][4][2];
#pragma unroll
    for (int a = 0; a < 2; ++a)
#pragma unroll
        for (int b = 0; b < 2; ++b)
#pragma unroll
            for (int m = 0; m < 4; ++m)
#pragma unroll
                for (int n = 0; n < 2; ++n) acc[a][b][m][n] = (f32x4){0.f, 0.f, 0.f, 0.f};
    bf16x8 At[4][2], B0[2][2], B1[2][2];
    const char* cA = (const char*)g.A + (size_t)cur.pm * tstep; const char* cB = (const char*)g.Bt + (size_t)cur.pn * tstep;
    S.a_ready(cur);
    if constexpr (SP2) {
        PG8_STAGE(PG8_SB(0, 0), cB, voffB); PG8_STAGE(PG8_SB(0, 1), cB + hstep, voffB); PG8_STAGE(PG8_SA(0, 0), cA, voffA); PG8_STAGE(PG8_SA(0, 1), cA + hstep, voffA);
        if (wr == 1) PG8_BAR;
        PG8_WAIT_V(2); PG8_BAR;
        PG8_STAGE(PG8_SB(1, 0), cB + kstep, voffB); PG8_STAGE(PG8_SA(1, 0), cA + kstep, voffA); PG8_STAGE(PG8_SB(1, 1), cB + hstep + kstep, voffB);
        PG8_WAIT_V(6); PG8_BAR;
    } else {
        PG8_STAGE(PG8_SB(0, 0), cB, voffB); PG8_STAGE(PG8_SA(0, 0), cA, voffA); PG8_STAGE(PG8_SB(0, 1), cB + hstep, voffB); PG8_STAGE(PG8_SA(0, 1), cA + hstep, voffA);
        if (wr == 1) PG8_BAR;
        PG8_WAIT_V(4); PG8_BAR;
        PG8_STAGE(PG8_SB(1, 0), cB + kstep, voffB); PG8_STAGE(PG8_SA(1, 0), cA + kstep, voffA); PG8_STAGE(PG8_SB(1, 1), cB + hstep + kstep, voffB);
        PG8_WAIT_V(6); PG8_BAR;
    }
    for (;;) {
        const bool has_next = S.next(ui + 1, nxt);
        const char* nA = has_next ? (const char*)g.A + (size_t)nxt.pm * tstep : cA; const char* nB = has_next ? (const char*)g.Bt + (size_t)nxt.pn * tstep : cB;
        for (int t = 0; t < nt; t += 2) {
            const bool last = (t == nt - 2);
            const char* a1 = cA + (size_t)(t + 1) * kstep;
            const char* a2 = last ? nA : cA + (size_t)(t + 2) * kstep; const char* b2 = last ? nB : cB + (size_t)(t + 2) * kstep;
            const char* a3 = a2 + kstep; const char* b3 = b2 + kstep;
            if (last && has_next) S.a_ready(nxt);
            if constexpr (SP2) {
            PG8_LDB(B0, 0, 0); PG8_LDB(B1, 0, 1); PG8_SCHED; PG8_LDA(At, 0, 0); PG8_STAGE(PG8_SA(1, 1), a1 + hstep, voffA);
            PG8_WAIT_V(8); PG8_WAIT_L(0); PG8_BAR; PG8_MMA(0, 0, At, B0); PG8_MMA(0, 1, At, B1); PG8_BAR; PG8_SCHED;
            PG8_LDA(At, 0, 1); PG8_STAGE(PG8_SB(0, 0), b2, voffB); PG8_STAGE(PG8_SB(0, 1), b2 + hstep, voffB); PG8_STAGE(PG8_SA(0, 0), a2, voffA);
            PG8_WAIT_V(8); PG8_WAIT_L(0); PG8_BAR; PG8_MMA(1, 0, At, B0); PG8_MMA(1, 1, At, B1); PG8_BAR; PG8_SCHED;
            PG8_LDB(B0, 1, 0); PG8_LDB(B1, 1, 1); PG8_SCHED; PG8_LDA(At, 1, 0); PG8_STAGE(PG8_SA(0, 1), a2 + hstep, voffA);
            PG8_WAIT_V(8); PG8_WAIT_L(0); PG8_BAR; PG8_MMA(0, 0, At, B0); PG8_MMA(0, 1, At, B1); PG8_BAR; PG8_SCHED;
            PG8_LDA(At, 1, 1); PG8_STAGE(PG8_SB(1, 0), b3, voffB); PG8_STAGE(PG8_SB(1, 1), b3 + hstep, voffB); PG8_STAGE(PG8_SA(1, 0), a3, voffA);
            PG8_WAIT_V(8); PG8_WAIT_L(0); PG8_BAR; PG8_MMA(1, 0, At, B0); PG8_MMA(1, 1, At, B1); PG8_BAR; PG8_SCHED;
            } else {
            PG8_LDB(B0, 0, 0); PG8_SCHED; PG8_LDA(At, 0, 0); PG8_STAGE(PG8_SA(1, 1), a1 + hstep, voffA);
            PG8_WAIT_L(8); PG8_BAR; PG8_WAIT_L(0); PG8_MMA(0, 0, At, B0); PG8_BAR; PG8_SCHED;
            PG8_LDB(B1, 0, 1); PG8_STAGE(PG8_SB(0, 0), b2, voffB);
            PG8_BAR; PG8_WAIT_L(0); PG8_MMA(0, 1, At, B1); PG8_BAR;
            PG8_LDA(At, 0, 1); PG8_STAGE(PG8_SA(0, 0), a2, voffA);
            PG8_BAR; PG8_WAIT_L(0); PG8_MMA(1, 0, At, B0); PG8_BAR; PG8_SCHED;
            PG8_STAGE(PG8_SB(0, 1), b2 + hstep, voffB);
            PG8_WAIT_V(6); PG8_BAR; PG8_MMA(1, 1, At, B1); PG8_BAR;
            PG8_LDB(B0, 1, 0); PG8_SCHED; PG8_LDA(At, 1, 0); PG8_STAGE(PG8_SA(0, 1), a2 + hstep, voffA);
            PG8_WAIT_L(8); PG8_BAR; PG8_WAIT_L(0); PG8_MMA(0, 0, At, B0); PG8_BAR; PG8_SCHED;
            PG8_LDB(B1, 1, 1); PG8_STAGE(PG8_SB(1, 0), b3, voffB);
            PG8_BAR; PG8_WAIT_L(0); PG8_MMA(0, 1, At, B1); PG8_BAR;
            PG8_LDA(At, 1, 1); PG8_STAGE(PG8_SA(1, 0), a3, voffA);
            PG8_BAR; PG8_WAIT_L(0); PG8_MMA(1, 0, At, B0); PG8_BAR; PG8_SCHED;
            PG8_STAGE(PG8_SB(1, 1), b3 + hstep, voffB);
            PG8_WAIT_V(6); PG8_BAR; PG8_MMA(1, 1, At, B1); PG8_BAR;
            }
        }
        if constexpr (ALIGN_EPI) { if (wr == 0) PG8_BAR; }
        if constexpr (!Epi::AFTER_DRAIN) { E(acc, cur, wr, wc, fr, fq); S.done(cur); }
        if (!has_next) break;
#pragma unroll
        for (int a = 0; a < 2; ++a)
#pragma unroll
            for (int b = 0; b < 2; ++b)
#pragma unroll
                for (int m = 0; m < 4; ++m)
#pragma unroll
                    for (int n = 0; n < 2; ++n) acc[a][b][m][n] = (f32x4){0.f, 0.f, 0.f, 0.f};
        cur = nxt; cA = nA; cB = nB; ++ui;
        if constexpr (ALIGN_EPI) { if (wr == 1) PG8_BAR; }
    }
    PG8_WAIT_V(0);
    if constexpr (!ALIGN_EPI) { if (wr == 0) PG8_BAR; }
    PG8_BAR;
    if constexpr (Epi::AFTER_DRAIN) { E.fused(acc, cur, wr, wc, fr, fq, lds, wid, lane); S.done(cur); }
#undef PG8_SA
#undef PG8_SB
#undef PG8_STAGE
#undef PG8_LDA
#undef PG8_LDB
#undef PG8_MMA
#undef PG8_WAIT_V
#undef PG8_WAIT_L
#undef PG8_BAR
#undef PG8_SCHED
}
}
constexpr int NWAVES = 8;
constexpr int DM = 1024, NBATCH = 16, SEQ = 2048, MT = NBATCH * SEQ, DFF = 2816, MEML = 256, MR = NBATCH * MEML, INDIM = 3088, NWIN = 3328, ZW = 3072, DEPTH = 2;
constexpr float EPS = 1e-6f;
constexpr int NPHASE = 2 + 15 * DEPTH;
constexpr size_t MiB = 1u << 20;
constexpr size_t WS_CTL = 0, CTL_ZERO_BYTES = 1 * MiB;
constexpr size_t WS_W = 2 * MiB, W_LSTRIDE = 46 * MiB;
constexpr size_t WO_GU1 = 0, WO_D1 = 11 * MiB, WO_WIN = 16 * MiB + 512 * 1024, WO_OUT = 23 * MiB, WO_Q = 25 * MiB, WO_O = 27 * MiB, WO_GU2 = 29 * MiB, WO_D2 = 40 * MiB;
constexpr size_t WS_WK = 94 * MiB, WS_WV = 98 * MiB;
constexpr size_t WS_COS = 102 * MiB, WS_SIN = 106 * MiB;
constexpr size_t WS_RSX = 110 * MiB, WS_RSM = 110 * MiB + 512 * 1024;
constexpr size_t WS_MEMN = 111 * MiB;
constexpr size_t WS_K = 119 * MiB, WS_VT = 135 * MiB;
constexpr size_t WS_XB = 152 * MiB;
constexpr size_t WS_R1 = 216 * MiB;
constexpr size_t WS_BIG = 280 * MiB;
constexpr size_t WS_LA = WS_BIG + 192 * MiB, WS_END = 512 * MiB;
constexpr int CW_TMO = 0, CW_BAR = 4096;

#define GAS __attribute__((address_space(1)))
#define LAS __attribute__((address_space(3)))
typedef unsigned short bf16;
typedef unsigned v4u __attribute__((ext_vector_type(4)));
typedef unsigned v2u __attribute__((ext_vector_type(2)));
typedef float f32x4 __attribute__((ext_vector_type(4)));
#define LDS_WAIT() asm volatile("s_waitcnt lgkmcnt(0)" ::: "memory")
#define VM_WAIT() asm volatile("s_waitcnt vmcnt(0)" ::: "memory")
__device__ __forceinline__ unsigned f2bf(float f) { unsigned u = __builtin_bit_cast(unsigned, f); return (u + 0x7fffu + ((u >> 16) & 1u)) >> 16; }
__device__ __forceinline__ unsigned pk2(float lo, float hi) { return f2bf(lo) | (f2bf(hi) << 16); }
__device__ __forceinline__ float bflo(unsigned w) { return __builtin_bit_cast(float, w << 16); }
__device__ __forceinline__ float bfhi(unsigned w) { return __builtin_bit_cast(float, w & 0xffff0000u); }
__device__ __forceinline__ float bf2f(bf16 b) { return __builtin_bit_cast(float, (unsigned)b << 16); }
__device__ __forceinline__ float wave_sum(float v) {
#pragma unroll
    for (int o = 1; o < 64; o <<= 1) v += __shfl_xor(v, o);
    return v;
}

#define XB_TMO      128
#define XB_XCNT(j)  (256  + 64 * (j))
#define XB_XSUB(j)  (1280 + 64 * (j))
#define XB_XGEN(j)  (2304 + 64 * (j))
#define XB_TOP      3328
#define XB_TOPGEN   3392
#define XCD_BAR_WORDS 3456
#define XB_SPIN_CAP (1u << 18)

__device__ __forceinline__ unsigned xb_ld(unsigned* p)              { return __hip_atomic_load(p, __ATOMIC_RELAXED, __HIP_MEMORY_SCOPE_AGENT); }
__device__ __forceinline__ unsigned xb_add(unsigned* p, unsigned v) { return __hip_atomic_fetch_add(p, v, __ATOMIC_RELAXED, __HIP_MEMORY_SCOPE_AGENT); }
__device__ __forceinline__ unsigned xb_xcc_id() { return (unsigned)__builtin_amdgcn_s_getreg((3 << 11) | 20) & 0xFu; }
#define XB_SPIN(cond, bar) do { unsigned _sp = 0; while (cond) { __builtin_amdgcn_s_sleep(1); \
    if ((++_sp & 255u) == 0u) { if (xb_ld(&(bar)[XB_TMO])) break; if (_sp > XB_SPIN_CAP) { atomicAdd(&(bar)[XB_TMO], 1u); break; } } } } while (0)

struct XcdBarrier {
    unsigned* bar; unsigned x;
    volatile LAS unsigned* st;
};

__device__ __forceinline__ XcdBarrier xcd_barrier_post(unsigned* bar, volatile LAS unsigned* st) {
    XcdBarrier b; b.bar = bar; b.x = xb_xcc_id(); b.st = st;
    if (threadIdx.x == 0) (void)xb_add(&bar[XB_XCNT(b.x)], 1u);
    return b;
}
__device__ __forceinline__ void xcd_barrier_complete(unsigned* bar, unsigned x, unsigned& nloc, unsigned& nx) {
    const unsigned G = gridDim.x * gridDim.y * gridDim.z;
    unsigned sum, cnt, mine, sp = 0u;
    for (;;) {
        sum = 0u; cnt = 0u; mine = 0u;
#pragma unroll
        for (unsigned j = 0; j < 16; ++j) { const unsigned c = xb_ld(&bar[XB_XCNT(j)]); sum += c; cnt += (c > 0u) ? 1u : 0u; mine = (j == x) ? c : mine; }
        if (sum == G) break;
        __builtin_amdgcn_s_sleep(1);
        if ((++sp & 255u) == 0u) { if (xb_ld(&bar[XB_TMO])) break; if (sp > XB_SPIN_CAP) { atomicAdd(&bar[XB_TMO], 1u); break; } }
    }
    nloc = mine > 0u ? mine : 1u; nx = cnt > 0u ? cnt : 1u;
}

__device__ __forceinline__ void xcd_barrier(const XcdBarrier& b) {
    asm volatile("s_waitcnt vmcnt(0)" ::: "memory");
    __syncthreads();
    if (threadIdx.x == 0) {
        unsigned* bar = b.bar;
        __builtin_amdgcn_s_waitcnt(0);
        unsigned nloc = b.st[0], nx = b.st[1];
        if (nloc == 0u) { xcd_barrier_complete(bar, b.x, nloc, nx); b.st[0] = nloc; b.st[1] = nx; }
        const unsigned old = xb_add(&bar[XB_XSUB(b.x)], 1u);
        const unsigned gen = old / nloc;
        if (old + 1u == (gen + 1u) * nloc) {
            __builtin_amdgcn_fence(__ATOMIC_RELEASE, "agent");
            asm volatile("s_waitcnt vmcnt(0)" ::: "memory");
            const unsigned og = xb_add(&bar[XB_TOP], 1u);
            const unsigned tg = og / nx;
            if (og + 1u == (tg + 1u) * nx) xb_add(&bar[XB_TOPGEN], 1u);
            else XB_SPIN(xb_ld(&bar[XB_TOPGEN]) == tg, bar);
            __builtin_amdgcn_fence(__ATOMIC_ACQUIRE, "agent");
            xb_add(&bar[XB_XGEN(b.x)], 1u);
            asm volatile("s_waitcnt vmcnt(0)" ::: "memory");
        } else {
            XB_SPIN(xb_ld(&bar[XB_XGEN(b.x)]) == gen, bar);
            __builtin_amdgcn_fence(__ATOMIC_ACQUIRE, "agent");
            asm volatile("s_waitcnt vmcnt(0)" ::: "memory");
        }
    }
    __syncthreads();
}

struct Args { const float* in[27]; float* out; unsigned char* ws; int ph_lo, ph_hi, li, pad; };

struct Sec { const float* W; const float* gk; bf16* Bt; int ldw, col0, ncols, K, mode, row_off; float scale; };
__device__ __forceinline__ int dst_map(int mode, int j) {
    if (mode == 1) { const int hd = j >> 6, o = j & 63, x2 = o >> 5, oo = o & 31; return (hd << 6) + 8 * (oo >> 2) + 4 * x2 + (oo & 3); }
    if (mode == 2) return 256 * (j >> 7) + (j & 127);
    return j;
}
__device__ __forceinline__ void xpose_item(const Sec& s, LAS float* scr, int item, int lane) {
    const int nblk = s.ncols / 32, kb = item / nblk, nb = item % nblk, k0 = 64 * kb, n0 = 32 * nb;
#pragma unroll 8
    for (int i = 0; i < 32; ++i) { const int kk = 2 * i + (lane >> 5), k = k0 + kk; float w = s.W[(size_t)k * s.ldw + s.col0 + n0 + (lane & 31)]; if (s.gk) w *= s.gk[k]; scr[kk * 33 + (lane & 31)] = w * s.scale; }
    LDS_WAIT(); asm volatile("" ::: "memory");
    const int c = lane & 7;
#pragma unroll
    for (int j = 0; j < 4; ++j) { const int n = (lane >> 3) + 8 * j; const LAS float* p = scr + (8 * c) * 33 + n;
        v4u o; o.x = pk2(p[0 * 33], p[1 * 33]); o.y = pk2(p[2 * 33], p[3 * 33]); o.z = pk2(p[4 * 33], p[5 * 33]); o.w = pk2(p[6 * 33], p[7 * 33]);
        *(GAS v4u*)(s.Bt + (size_t)(s.row_off + dst_map(s.mode, n0 + n)) * s.K + k0 + 8 * c) = o; }
    LDS_WAIT(); asm volatile("" ::: "memory");
}
__device__ __forceinline__ void row_cvt(const float* xrow, bf16* orow, float* rs_out, int lane) {
    const GAS f32x4* xr = (const GAS f32x4*)xrow + lane;
    f32x4 v[4]; float s = 0.f;
#pragma unroll
    for (int j = 0; j < 4; ++j) { v[j] = xr[64 * j]; s += (v[j].x * v[j].x + v[j].y * v[j].y) + (v[j].z * v[j].z + v[j].w * v[j].w); }
    s = wave_sum(s);
    GAS v2u* o8 = (GAS v2u*)orow + lane;
#pragma unroll
    for (int j = 0; j < 4; ++j) { v2u w; w.x = pk2(v[j].x, v[j].y); w.y = pk2(v[j].z, v[j].w); o8[64 * j] = w; }
    if (lane == 0) *rs_out = 1.0f / sqrtf(s * (1.0f / DM) + EPS);
}
__device__ __forceinline__ void thin_row(const float* xin, const bf16* yrow, const float* g, float coef, float* xout, bf16* xb, float* rs_out, int lane) {
    const GAS v2u* yr = (const GAS v2u*)yrow + lane;
    f32x4 y[4]; float s = 0.f;
#pragma unroll
    for (int j = 0; j < 4; ++j) { const v2u w = yr[64 * j]; y[j] = (f32x4){bflo(w.x), bfhi(w.x), bflo(w.y), bfhi(w.y)}; s += (y[j].x * y[j].x + y[j].y * y[j].y) + (y[j].z * y[j].z + y[j].w * y[j].w); }
    const float ry = coef / sqrtf(wave_sum(s) * (1.0f / DM) + EPS);
    const GAS f32x4* xr = (const GAS f32x4*)xin + lane; const GAS f32x4* gr = (const GAS f32x4*)g + lane;
    GAS f32x4* xo = (GAS f32x4*)xout + lane; GAS v2u* o8 = (GAS v2u*)xb + lane; float s2 = 0.f;
#pragma unroll
    for (int j = 0; j < 4; ++j) { const f32x4 xn = xr[64 * j] + y[j] * ry * gr[64 * j]; xo[64 * j] = xn; v2u w; w.x = pk2(xn.x, xn.y); w.y = pk2(xn.z, xn.w); o8[64 * j] = w;
        s2 += (xn.x * xn.x + xn.y * xn.y) + (xn.z * xn.z + xn.w * xn.w); }
    s2 = wave_sum(s2);
    if (lane == 0) *rs_out = 1.0f / sqrtf(s2 * (1.0f / DM) + EPS);
}


#define CAS __attribute__((address_space(4)))
__device__ __forceinline__ int opq(int v) { asm volatile("" : "+s"(v)); return v; }
__device__ __forceinline__ const CAS unsigned char* karg_opaque() { const CAS unsigned char* k = (const CAS unsigned char*)__builtin_amdgcn_kernarg_segment_ptr(); asm volatile("" : "+s"(k)); return k; }
#define PIN(i) (*(const float* const CAS*)(karg_opaque() + 8 * (i)))
#define POUT (*(float* const CAS*)(karg_opaque() + 8 * 27))
#define WSP(off) (*(unsigned char* const CAS*)(karg_opaque() + 8 * 28) + (off))
__global__ void __launch_bounds__(NWAVES * 64, 2) mk_fwd(Args args) {
    extern __shared__ __attribute__((aligned(16))) unsigned char lds_raw[];
    LAS unsigned char* lds = (LAS unsigned char*)lds_raw;
    const int wave = __builtin_amdgcn_readfirstlane(threadIdx.x >> 6);
    const int G = gridDim.x, bx = blockIdx.x;
    const int vcu = (G % 8 == 0) ? (bx % 8) * (G / 8) + bx / 8 : bx;

    volatile LAS unsigned* MISC = (volatile LAS unsigned*)(lds + 131072 + 320);
    for (int u = threadIdx.x; u < (147456 - 131072) / 4; u += NWAVES * 64) ((LAS unsigned*)(lds + 131072))[u] = 0u;
    __syncthreads();
    XcdBarrier bar = xcd_barrier_post((unsigned*)WSP(WS_CTL) + CW_BAR + args.li * XCD_BAR_WORDS, MISC + 8);
    const int lo = args.ph_lo, hi = args.ph_hi;
#define IN(k) (lo <= (k) && (k) < hi)
#define SEAM(k) do { if (IN(k) && IN((k) + 1)) xcd_barrier(bar); } while (0)
    const int gw = vcu * NWAVES + wave, NGW = G * NWAVES, NT = G * NWAVES * 64;
#define LANE_DECL int lane_ = threadIdx.x & 63; asm volatile("" : "+v"(lane_)); const int lane = lane_
#define rsx ((float*)WSP(WS_RSX))
#define rsm ((float*)WSP(WS_RSM))
#define XB ((bf16*)WSP(WS_XB))
#define R1 ((bf16*)WSP(WS_R1))
#define BIG ((bf16*)WSP(WS_BIG))
#define LA ((float*)WSP(WS_LA))
#define MEMN ((bf16*)WSP(WS_MEMN))
#define KB ((bf16*)WSP(WS_K))
#define VT ((bf16*)WSP(WS_VT))
#define cosT ((float*)WSP(WS_COS))
#define sinT ((float*)WSP(WS_SIN))
    if (IN(0)) {
        LANE_DECL; const int gtid = (vcu * NWAVES * 64) + (int)threadIdx.x;
        LAS float* scr = (LAS float*)(lds + wave * 16384);
        constexpr int C_GU = 16 * 88, C_D = 44 * 32, C_128 = 16 * 4 * 2, C_256 = 16 * 8 * 2, C_SQ = 16 * 32, PER_L = 6 * C_GU   + 4 * C_128 + 4 * C_256 + 5 * C_SQ;
        static_assert(C_GU == C_D && PER_L == 12544, "item counts");
        for (int it = gw; it < DEPTH * PER_L; it += NGW) {
            const int l = it / PER_L; int r = it % PER_L; Sec s; bool found = false;
            const size_t wl = WS_W + (size_t)l * W_LSTRIDE;
            const float* gF1 = PIN(3) + l * DM; const float* gMix = PIN(8) + l * DM; const float* gXa = PIN(16) + l * DM; const float* gMem = PIN(17) + l * DM; const float* gF2 = PIN(22) + l * DM;
            const float* w_in = PIN(9) + (size_t)l * DM * INDIM; const float* w_kv = PIN(19) + (size_t)l * DM * 2048;
#define SEC(cnt, W_, ldw_, col0_, ncols_, K_, gk_, scale_, Bt_, mode_, roff_) if (!found) { if (r < (cnt)) { s.W = (W_); s.ldw = (ldw_); s.col0 = (col0_); s.ncols = (ncols_); s.K = (K_); s.gk = (gk_); s.scale = (scale_); s.Bt = (bf16*)(Bt_); s.mode = (mode_); s.row_off = (roff_); found = true; } else r -= (cnt); }
            SEC(C_GU, PIN(4) + (size_t)l * DM * DFF, DFF, 0, DFF, DM, gF1, 1.f, WSP(wl + WO_GU1), 2, 0)
            SEC(C_GU, PIN(5) + (size_t)l * DM * DFF, DFF, 0, DFF, DM, gF1, 1.f, WSP(wl + WO_GU1), 2, 128)
            SEC(C_D, PIN(6) + (size_t)l * DFF * DM, DM, 0, DM, DFF, nullptr, 1.f, WSP(wl + WO_D1), 0, 0)
            SEC(C_128, w_in, INDIM, 0, 256, DM, gMix, 1.f, WSP(wl + WO_WIN), 1, 0)
            SEC(C_128, w_in, INDIM, 256, 256, DM, gMix, 0.125f, WSP(wl + WO_WIN), 1, 256)
            SEC(C_256, w_in, INDIM, 512, 512, DM, gMix, 1.f, WSP(wl + WO_WIN), 0, 512)
            SEC(C_256, w_in, INDIM, 1024, 512, DM, gMix, 1.f, WSP(wl + WO_WIN), 0, 1024)
            SEC(C_128, w_in, INDIM, 1536, 256, DM, gMix, 0.125f, WSP(wl + WO_WIN), 0, 1536)
            SEC(C_128, w_in, INDIM, 1792, 256, DM, gMix, 1.f, WSP(wl + WO_WIN), 0, 1792)
            SEC(C_256, w_in, INDIM, 2048, 512, DM, gMix, 1.f, WSP(wl + WO_WIN), 0, 2048)
            SEC(C_256, w_in, INDIM, 2576, 512, DM, gMix, 1.f, WSP(wl + WO_WIN), 0, 2560)
            SEC(C_SQ, PIN(14) + (size_t)l * DM * DM, DM, 0, DM, DM, nullptr, 1.f, WSP(wl + WO_OUT), 0, 0)
            SEC(C_SQ, PIN(18) + (size_t)l * DM * DM, DM, 0, DM, DM, gXa, 0.0625f, WSP(wl + WO_Q), 0, 0)
            SEC(C_SQ, PIN(20) + (size_t)l * DM * DM, DM, 0, DM, DM, nullptr, 1.f, WSP(wl + WO_O), 0, 0)
            SEC(C_SQ, w_kv, 2048, 0, DM, DM, gMem, 1.f, WSP(WS_WK), 0, l * DM)
            SEC(C_SQ, w_kv, 2048, DM, DM, DM, gMem, 1.f, WSP(WS_WV), 0, l * DM)
            SEC(C_GU, PIN(23) + (size_t)l * DM * DFF, DFF, 0, DFF, DM, gF2, 1.f, WSP(wl + WO_GU2), 2, 0)
            SEC(C_GU, PIN(24) + (size_t)l * DM * DFF, DFF, 0, DFF, DM, gF2, 1.f, WSP(wl + WO_GU2), 2, 128)
            SEC(C_D, PIN(25) + (size_t)l * DFF * DM, DM, 0, DM, DFF, nullptr, 1.f, WSP(wl + WO_D2), 0, 0)
#undef SEC
            if (found) xpose_item(s, scr, r, lane);
        }
        for (int idx = gtid; idx < DEPTH * 256 * DM; idx += NT) { const int l = idx >> 18, c = (idx >> 10) & 255, k = idx & 1023;
            const float* wi = PIN(9) + (size_t)l * DM * INDIM + (size_t)k * INDIM + 2560; const float* wa = PIN(10) + l * 16 * 256 + c; float s = 0.f;
#pragma unroll
            for (int r = 0; r < 16; ++r) s += wi[r] * wa[r * 256];
            s *= PIN(8)[l * DM + k];
            ((bf16*)WSP(WS_W + (size_t)l * W_LSTRIDE + WO_WIN))[(size_t)(3072 + c) * DM + k] = (bf16)f2bf(s); }
        { const int* pos = (const int*)PIN(2);
          for (int idx = gtid; idx < MT * 32; idx += NT) { const int m = idx >> 5, f = idx & 31;
            double inv = 1.0; if (f & 1) inv *= 0.7498942093324559; if (f & 2) inv *= 0.5623413251903492; if (f & 4) inv *= 0.316227766016838; if (f & 8) inv *= 0.1; if (f & 16) inv *= 0.01;
            const double ang = (double)pos[m] * inv, j = __builtin_rint(ang * 0.6366197723675814);
            const double rr = __builtin_fma(-j, 6.123233995736766e-17, __builtin_fma(-j, 1.5707963267948966, ang)), z = rr * rr;
            const double sn = rr * (1.0 + z * (-1.0 / 6 + z * (1.0 / 120 + z * (-1.0 / 5040 + z * (1.0 / 362880 + z * (-1.0 / 39916800 + z * (1.0 / 6227020800.0)))))));
            const double cs = 1.0 + z * (-0.5 + z * (1.0 / 24 + z * (-1.0 / 720 + z * (1.0 / 40320 + z * (-1.0 / 3628800 + z * (1.0 / 479001600.0))))));
            const int q = (int)j & 3; const double c = (q == 0) ? cs : (q == 1) ? -sn : (q == 2) ? -cs : sn, s = (q == 0) ? sn : (q == 1) ? cs : (q == 2) ? -sn : -cs;
            cosT[idx] = (float)c; sinT[idx] = (float)s; } }
        for (int m = gw; m < MT; m += NGW) row_cvt(PIN(0) + (size_t)m * DM, XB + (size_t)m * DM, rsx + m, lane);
        for (int m = gw; m < MR; m += NGW) row_cvt(PIN(1) + (size_t)m * DM, MEMN + (size_t)m * DM, rsm + m, lane);
        __syncthreads();
    }
    SEAM(0);
    if (IN(1)) {
        if (bx < 128) { pg8::Gemm g{MEMN, (const bf16*)WSP(WS_WK), MR, 2048, DM}; pg8::StaticOrder S; S.init(MR, 2048, 128, bx);
            pg8::EpiRowScale E{KB, 2048, rsm}; pg8::gemm_phase<pg8::EpiRowScale, pg8::StaticOrder, false, true>(lds, g, S, E); }
        else { pg8::Gemm g{(const bf16*)WSP(WS_WV), MEMN, 2048, MR, DM}; pg8::StaticOrder S; S.init(2048, MR, 128, bx - 128);
            pg8::EpiColScale E{VT, MR, rsm}; pg8::gemm_phase<pg8::EpiColScale, pg8::StaticOrder, false, true>(lds, g, S, E); }
    }
    SEAM(1);
    for (int l = 0; l < DEPTH; ++l) {
        const int pb = 2 + 15 * l;
        const size_t wl = WS_W + (size_t)l * W_LSTRIDE;
        const float* xin = (l == 0) ? PIN(0) : POUT;
        if (IN(pb + 0)) { pg8::Gemm g{XB, (const bf16*)WSP(wl + WO_GU1), MT, 2 * DFF, DM}; pg8::StaticOrder S; S.init(MT, 2 * DFF, opq(G), opq(bx));
            pg8::EpiGU E{BIG, DFF, rsx}; pg8::gemm_phase<pg8::EpiGU, pg8::StaticOrder, true, true>(lds, g, S, E); }
        SEAM(pb + 0);
        if (IN(pb + 1)) { pg8::Gemm g{BIG, (const bf16*)WSP(wl + WO_D1), MT, DM, DFF}; pg8::StaticOrder S; S.init(MT, DM, opq(G), opq(bx));
            pg8::EpiPlain E{R1, DM}; pg8::gemm_phase<pg8::EpiPlain, pg8::StaticOrder, true, true>(lds, g, S, E); }
        SEAM(pb + 1);
        if (IN(pb + 2)) { LANE_DECL; const float* gp = PIN(7) + l * DM;
            for (int m = gw; m < MT; m += NGW) thin_row(xin + (size_t)m * DM, R1 + (size_t)m * DM, gp, 0.5f, POUT + (size_t)m * DM, XB + (size_t)m * DM, rsx + m, lane); }
        SEAM(pb + 2);
        if (IN(pb + 3)) { pg8::Gemm g{XB, (const bf16*)WSP(wl + WO_WIN), MT, NWIN, DM}; pg8::StaticOrder S; S.init(MT, NWIN, opq(G), opq(bx));
            pg8::EpiWin E{BIG, LA, rsx, cosT, sinT, PIN(11) + l * 256}; pg8::gemm_phase<pg8::EpiWin, pg8::StaticOrder, true, true>(lds, g, S, E); }
        SEAM(pb + 3);
        if (IN(pb + 4)) { }
        SEAM(pb + 4);
        if (IN(pb + 5)) { }
        SEAM(pb + 5);
        if (IN(pb + 6)) { pg8::Gemm g{R1, (const bf16*)WSP(wl + WO_OUT), MT, DM, DM}; pg8::StaticOrder S; S.init(MT, DM, opq(G), opq(bx));
            pg8::EpiPlain E{BIG, DM}; pg8::gemm_phase<pg8::EpiPlain, pg8::StaticOrder, true, true>(lds, g, S, E); }
        SEAM(pb + 6);
        if (IN(pb + 7)) { LANE_DECL; const float* gp = PIN(15) + l * DM;
            for (int m = gw; m < MT; m += NGW) thin_row(POUT + (size_t)m * DM, BIG + (size_t)m * DM, gp, 1.0f, POUT + (size_t)m * DM, XB + (size_t)m * DM, rsx + m, lane); }
        SEAM(pb + 7);
        if (IN(pb + 8)) { pg8::Gemm g{XB, (const bf16*)WSP(wl + WO_Q), MT, DM, DM}; pg8::StaticOrder S; S.init(MT, DM, opq(G), opq(bx));
            pg8::EpiRowScale E{BIG, DM, rsx}; pg8::gemm_phase<pg8::EpiRowScale, pg8::StaticOrder, true, true>(lds, g, S, E); }
        SEAM(pb + 8);
        if (IN(pb + 9)) { }
        SEAM(pb + 9);
        if (IN(pb + 10)) { pg8::Gemm g{BIG + (size_t)MT * DM, (const bf16*)WSP(wl + WO_O), MT, DM, DM}; pg8::StaticOrder S; S.init(MT, DM, opq(G), opq(bx));
            pg8::EpiPlain E{R1, DM}; pg8::gemm_phase<pg8::EpiPlain, pg8::StaticOrder, true, true>(lds, g, S, E); }
        SEAM(pb + 10);
        if (IN(pb + 11)) { LANE_DECL; const float* gp = PIN(21) + l * DM;
            for (int m = gw; m < MT; m += NGW) thin_row(POUT + (size_t)m * DM, R1 + (size_t)m * DM, gp, 1.0f, POUT + (size_t)m * DM, XB + (size_t)m * DM, rsx + m, lane); }
        SEAM(pb + 11);
        if (IN(pb + 12)) { pg8::Gemm g{XB, (const bf16*)WSP(wl + WO_GU2), MT, 2 * DFF, DM}; pg8::StaticOrder S; S.init(MT, 2 * DFF, opq(G), opq(bx));
            pg8::EpiGU E{BIG, DFF, rsx}; pg8::gemm_phase<pg8::EpiGU, pg8::StaticOrder, true, true>(lds, g, S, E); }
        SEAM(pb + 12);
        if (IN(pb + 13)) { pg8::Gemm g{BIG, (const bf16*)WSP(wl + WO_D2), MT, DM, DFF}; pg8::StaticOrder S; S.init(MT, DM, opq(G), opq(bx));
            pg8::EpiPlain E{R1, DM}; pg8::gemm_phase<pg8::EpiPlain, pg8::StaticOrder, true, true>(lds, g, S, E); }
        SEAM(pb + 13);
        if (IN(pb + 14)) { LANE_DECL; const float* gp = PIN(26) + l * DM;
            for (int m = gw; m < MT; m += NGW) thin_row(POUT + (size_t)m * DM, R1 + (size_t)m * DM, gp, 0.5f, POUT + (size_t)m * DM, XB + (size_t)m * DM, rsx + m, lane); }
        SEAM(pb + 14);
    }
#undef IN
#undef SEAM
#undef rsx
#undef rsm
#undef XB
#undef R1
#undef BIG
#undef LA
#undef MEMN
#undef KB
#undef VT
#undef cosT
#undef sinT
}

__global__ void __launch_bounds__(128) naive_mixer(const bf16* Z, const float* LA, const float* ng_ret, const float* ng_gla, bf16* MO) {
    const int blk = blockIdx.x, grp = blk >> 6, b = (blk >> 2) & 15, h = blk & 3, dv = threadIdx.x;
    const int qoff = grp ? 1536 + 64 * h : 64 * h, koff = grp ? 1792 + 64 * h : 256 + 64 * h, voff = (grp ? 2048 : 512) + 128 * h, goff = (grp ? 2560 : 1024) + 128 * h;
    const float* ng = grp ? ng_gla : ng_ret;
    __shared__ float qs[64], ks[64], as[64], red[2];
    float S[64];
#pragma unroll
    for (int d = 0; d < 64; ++d) S[d] = 0.f;
    const float gamma = 1.0f - exp2f(-5.0f - (float)h);
    for (int t = 0; t < SEQ; ++t) {
        const size_t row = (size_t)b * SEQ + t;
        if (dv < 64) { qs[dv] = bf2f(Z[row * ZW + qoff + dv]); ks[dv] = bf2f(Z[row * ZW + koff + dv]); as[dv] = grp ? expf(LA[row * 256 + 64 * h + dv]) : gamma; }
        __syncthreads();
        const float v = bf2f(Z[row * ZW + voff + dv]); float o = 0.f;
#pragma unroll
        for (int d = 0; d < 64; ++d) { S[d] = as[d] * S[d] + ks[d] * v; o += qs[d] * S[d]; }
        const float ss = wave_sum(o * o);
        if ((dv & 63) == 0) red[dv >> 6] = ss;
        __syncthreads();
        const float r = 1.0f / sqrtf((red[0] + red[1]) * (1.0f / 128.0f) + EPS);
        MO[row * DM + grp * 512 + h * 128 + dv] = (bf16)f2bf(o * r * ng[h * 128 + dv] * bf2f(Z[row * ZW + goff + dv]));
        __syncthreads();
    }
}
__global__ void __launch_bounds__(256) naive_xattn(const bf16* Q, const bf16* KB, const bf16* VT, bf16* AO, int l) {
    const int h = blockIdx.x & 3, r0 = (blockIdx.x >> 2) * 4, b = r0 / SEQ, j = threadIdx.x;
    __shared__ float qs[4][256], ps[4][256], red[4][4];
    for (int i = 0; i < 4; ++i) qs[i][j] = bf2f(Q[(size_t)(r0 + i) * DM + h * 256 + j]);
    __syncthreads();
    const bf16* kr = KB + (size_t)(b * 256 + j) * 2048 + l * 1024 + h * 256;
    float s[4] = {0.f, 0.f, 0.f, 0.f};
    for (int d = 0; d < 256; ++d) { const float kv = bf2f(kr[d]);
#pragma unroll
        for (int i = 0; i < 4; ++i) s[i] += qs[i][d] * kv; }
    for (int i = 0; i < 4; ++i) { float m = s[i];
        for (int o = 1; o < 64; o <<= 1) m = fmaxf(m, __shfl_xor(m, o));
        if ((j & 63) == 0) red[i][j >> 6] = m; }
    __syncthreads();
    float e[4];
    for (int i = 0; i < 4; ++i) { const float m = fmaxf(fmaxf(red[i][0], red[i][1]), fmaxf(red[i][2], red[i][3])); e[i] = expf(s[i] - m); }
    __syncthreads();
    for (int i = 0; i < 4; ++i) { const float t = wave_sum(e[i]); if ((j & 63) == 0) red[i][j >> 6] = t; }
    __syncthreads();
    for (int i = 0; i < 4; ++i) ps[i][j] = e[i] / ((red[i][0] + red[i][1]) + (red[i][2] + red[i][3]));
    __syncthreads();
    const bf16* vr = VT + (size_t)(l * 1024 + h * 256 + j) * MR + b * 256;
    float o[4] = {0.f, 0.f, 0.f, 0.f};
    for (int k = 0; k < 256; ++k) { const float vv = bf2f(vr[k]);
#pragma unroll
        for (int i = 0; i < 4; ++i) o[i] += ps[i][k] * vv; }
    for (int i = 0; i < 4; ++i) AO[(size_t)(r0 + i) * DM + h * 256 + j] = (bf16)f2bf(o[i]);
}

constexpr int LDS_BYTES = 147456;
extern "C" void kernel_launch(void* const* d_in, const int* in_sizes, int n_in, void* d_out, int out_size, void* d_ws, size_t ws_size, hipStream_t stream) {
    static int grid = 0;
    if (grid == 0) {
        if (n_in != 27 || out_size != MT * DM || ws_size < WS_END) { fprintf(stderr, "kernel_launch: unexpected shapes (n_in %d out %d ws %zu)\n", n_in, out_size, ws_size); grid = -1; return; }
        if (hipFuncSetAttribute((const void*)mk_fwd, hipFuncAttributeMaxDynamicSharedMemorySize, LDS_BYTES) != hipSuccess) { fprintf(stderr, "kernel_launch: hipFuncSetAttribute failed\n"); grid = -1; return; }
        int dev = 0, cus = 0; (void)hipGetDevice(&dev); (void)hipDeviceGetAttribute(&cus, hipDeviceAttributeMultiprocessorCount, dev);
        int per_cu = 0; (void)hipOccupancyMaxActiveBlocksPerMultiprocessor(&per_cu, (const void*)mk_fwd, NWAVES * 64, LDS_BYTES); (void)hipGetLastError();
        if (cus < 256 || per_cu < 1) fprintf(stderr, "kernel_launch: note: %d CUs, occupancy %d\n", cus, per_cu);
        grid = 256;
    }
    if (grid < 0) return;
    (void)hipMemsetAsync((char*)d_ws + WS_CTL, 0, CTL_ZERO_BYTES, stream);
    Args a{};
    for (int i = 0; i < 27; ++i) a.in[i] = (const float*)d_in[i];
    a.out = (float*)d_out; a.ws = (unsigned char*)d_ws; a.pad = 0;
    unsigned char* ws = (unsigned char*)d_ws;
    int li = 0;
    auto run = [&](int lo, int hi) { a.ph_lo = lo; a.ph_hi = hi; a.li = li++; hipLaunchKernelGGL(mk_fwd, dim3(grid), dim3(NWAVES * 64), LDS_BYTES, stream, a); };
#if MK_ONE_LAUNCH
    run(0, NPHASE);
#else
    run(0, 1); run(1, 2);
    for (int l = 0; l < DEPTH; ++l) { const int pb = 2 + 15 * l;
        run(pb + 0, pb + 1); run(pb + 1, pb + 2); run(pb + 2, pb + 3); run(pb + 3, pb + 4);
        hipLaunchKernelGGL(naive_mixer, dim3(128), dim3(128), 0, stream, (const bf16*)(ws + WS_BIG), (const float*)(ws + WS_LA), (const float*)d_in[12] + l * 512, (const float*)d_in[13] + l * 512, (bf16*)(ws + WS_R1));
        run(pb + 6, pb + 7); run(pb + 7, pb + 8); run(pb + 8, pb + 9);
        hipLaunchKernelGGL(naive_xattn, dim3(MT), dim3(256), 0, stream, (const bf16*)(ws + WS_BIG), (const bf16*)(ws + WS_K), (const bf16*)(ws + WS_VT), (bf16*)(ws + WS_BIG) + (size_t)MT * DM, l);
        run(pb + 10, pb + 11); run(pb + 11, pb + 12); run(pb + 12, pb + 13); run(pb + 13, pb + 14); run(pb + 14, pb + 15);
    }
#endif
}
```

```cpp
#include <hip/hip_runtime.h>
#include <cstdio>
#include <cstdint>
#ifndef MK_ONE_LAUNCH
#define MK_ONE_LAUNCH 1
#endif
#ifndef FAST_MIXER
#define FAST_MIXER 1
#endif
#ifndef FAST_XATTN
#define FAST_XATTN 1
#endif
namespace pg8 {
#define PG8_LAS __attribute__((address_space(3)))
typedef unsigned short bf16_t;
typedef short bf16x8 __attribute__((ext_vector_type(8)));
typedef float f32x4 __attribute__((ext_vector_type(4)));
typedef unsigned u32x4 __attribute__((ext_vector_type(4)));
constexpr int BM = 256, BK = 64, HALF = 128, HTB = HALF * BK * 2  , STAGE_BYTES = 8 * HTB, NXCD = 8, WGM = 8;

__host__ __device__ __forceinline__ int lds_byte(int r, int c) { const int st = (r >> 4) * 2 + (c >> 5), rr = r & 15, cc = c & 31, ob = rr * 64 + cc * 2; return st * 1024 + (ob ^ (((ob >> 9) & 1) << 5)); }
__host__ __device__ __forceinline__ void stage_rc(int b, int& R, int& C) { const int st = b / 1024, sb = b % 1024, swz = sb ^ (((sb >> 9) & 1) << 5); R = (st >> 1) * 16 + swz / 64; C = (st & 1) * 32 + (swz % 64) / 2; }
__host__ __device__ __forceinline__ int perm32(int rho) { const int n = rho >> 4, i = rho & 15; return 8 * (i >> 2) + 4 * n + (i & 3); }

struct Unit { int pm, pn; };
struct Gemm { const bf16_t* A; const bf16_t* Bt; int M, N, K; };

struct StaticOrder {
    int nM, nN, nwg, G, c;
    __host__ __device__ void init(int M, int N, int G_, int c_) { nM = M / BM; nN = N / BM; nwg = nM * nN; G = G_; c = c_; }
    __host__ __device__ bool next(int i, Unit& u) const {
        const long L = (long)i * G + c; if (L >= nwg) return false;
        int wgid = (int)L; { const int q = nwg / NXCD, r = nwg % NXCD, xcd = wgid % NXCD, off = wgid / NXCD; wgid = (xcd < r ? xcd * (q + 1) : r * (q + 1) + (xcd - r) * q) + off; }
        const int nig = WGM * nN, gid = wgid / nig, fm = gid * WGM, gsz = (nM - fm) < WGM ? (nM - fm) : WGM;
        u.pm = fm + ((wgid % nig) % gsz); u.pn = (wgid % nig) / gsz; return true;
    }
    __device__ __forceinline__ void a_ready(const Unit&) const {}
    __device__ __forceinline__ void done(const Unit&) const {}
};

__device__ __forceinline__ unsigned cvt_pk_bf16(float lo, float hi) { unsigned r; asm volatile("v_cvt_pk_bf16_f32 %0, %1, %2" : "=v"(r) : "v"(lo), "v"(hi)); return r; }
constexpr float RMS_EPS = 1e-6f;
typedef unsigned u32x2 __attribute__((ext_vector_type(2)));
__device__ __forceinline__ float sigmoid_f(float x) { return __builtin_amdgcn_rcpf(1.0f + __expf(-x)); }
__device__ __forceinline__ f32x4 silu4(f32x4 v) { f32x4 o; o[0] = v[0] * sigmoid_f(v[0]); o[1] = v[1] * sigmoid_f(v[1]); o[2] = v[2] * sigmoid_f(v[2]); o[3] = v[3] * sigmoid_f(v[3]); return o; }
__device__ __forceinline__ u32x4 pack8(f32x4 v0, f32x4 v1) { u32x4 w; w.x = cvt_pk_bf16(v0[0], v0[1]); w.y = cvt_pk_bf16(v0[2], v0[3]); w.z = cvt_pk_bf16(v1[0], v1[1]); w.w = cvt_pk_bf16(v1[2], v1[3]); return w; }

struct EpiPlain {
    static constexpr bool PERM = true, AFTER_DRAIN = false;
    bf16_t* O; int ldc;
    __device__ __forceinline__ void operator()(const f32x4 (&acc)[2][2][4][2], const Unit& u, int wr, int wc, int fr, int fq) const {
        const int row0 = u.pm * BM + wr * 64 + fr, col0 = u.pn * BM + wc * 32 + 8 * fq;
#pragma unroll
        for (int ai = 0; ai < 2; ++ai)
#pragma unroll
            for (int m = 0; m < 4; ++m) { bf16_t* rowp = O + (size_t)(row0 + ai * HALF + m * 16) * ldc + col0;
#pragma unroll
                for (int bj = 0; bj < 2; ++bj) *(u32x4*)(rowp + bj * HALF) = pack8(acc[ai][bj][m][0], acc[ai][bj][m][1]); }
    }
};
struct EpiRowScale {
    static constexpr bool PERM = true, AFTER_DRAIN = false;
    bf16_t* O; int ldc; const float* rs;
    __device__ __forceinline__ void operator()(const f32x4 (&acc)[2][2][4][2], const Unit& u, int wr, int wc, int fr, int fq) const {
        const int row0 = u.pm * BM + wr * 64 + fr, col0 = u.pn * BM + wc * 32 + 8 * fq;
#pragma unroll
        for (int ai = 0; ai < 2; ++ai)
#pragma unroll
            for (int m = 0; m < 4; ++m) { const int row = row0 + ai * HALF + m * 16; const float r = rs[row]; bf16_t* rowp = O + (size_t)row * ldc + col0;
#pragma unroll
                for (int bj = 0; bj < 2; ++bj) *(u32x4*)(rowp + bj * HALF) = pack8(acc[ai][bj][m][0] * r, acc[ai][bj][m][1] * r); }
    }
};
struct EpiColScale {
    static constexpr bool PERM = true, AFTER_DRAIN = false;
    bf16_t* O; int ldc; const float* cs;
    __device__ __forceinline__ void operator()(const f32x4 (&acc)[2][2][4][2], const Unit& u, int wr, int wc, int fr, int fq) const {
        const int row0 = u.pm * BM + wr * 64 + fr, col0 = u.pn * BM + wc * 32 + 8 * fq;
        f32x4 s[2][2];
#pragma unroll
        for (int bj = 0; bj < 2; ++bj) { s[bj][0] = *(const f32x4*)(cs + col0 + bj * HALF); s[bj][1] = *(const f32x4*)(cs + col0 + bj * HALF + 4); }
#pragma unroll
        for (int ai = 0; ai < 2; ++ai)
#pragma unroll
            for (int m = 0; m < 4; ++m) { bf16_t* rowp = O + (size_t)(row0 + ai * HALF + m * 16) * ldc + col0;
#pragma unroll
                for (int bj = 0; bj < 2; ++bj) *(u32x4*)(rowp + bj * HALF) = pack8(acc[ai][bj][m][0] * s[bj][0], acc[ai][bj][m][1] * s[bj][1]); }
    }
};
struct EpiGU {
    static constexpr bool PERM = true, AFTER_DRAIN = false;
    bf16_t* H; int ldh; const float* rs;
    __device__ __forceinline__ void operator()(const f32x4 (&acc)[2][2][4][2], const Unit& u, int wr, int wc, int fr, int fq) const {
        const int row0 = u.pm * BM + wr * 64 + fr, col0 = u.pn * HALF + wc * 32 + 8 * fq;
#pragma unroll
        for (int ai = 0; ai < 2; ++ai)
#pragma unroll
            for (int m = 0; m < 4; ++m) { const int row = row0 + ai * HALF + m * 16; const float r = rs[row];
                const f32x4 h0 = silu4(acc[ai][0][m][0] * r) * (acc[ai][1][m][0] * r), h1 = silu4(acc[ai][0][m][1] * r) * (acc[ai][1][m][1] * r);
                *(u32x4*)(H + (size_t)row * ldh + col0) = pack8(h0, h1); }
    }
};
struct EpiWin {
    static constexpr bool PERM = true, AFTER_DRAIN = false;
    bf16_t* Z; float* LA; const float* rs; const float* cosT; const float* sinT; const float* ba2;
    __device__ __forceinline__ void operator()(const f32x4 (&acc)[2][2][4][2], const Unit& u, int wr, int wc, int fr, int fq) const {
        const int row0 = u.pm * BM + wr * 64 + fr, cin = wc * 32 + 8 * fq, pn = u.pn;
        if (pn <= 1) {
            const int f0 = 16 * (wc & 1) + 4 * fq;
#pragma unroll
            for (int ai = 0; ai < 2; ++ai)
#pragma unroll
                for (int m = 0; m < 4; ++m) { const int row = row0 + ai * HALF + m * 16; const float r = rs[row];
                    const f32x4 c4 = *(const f32x4*)(cosT + (size_t)row * 32 + f0), s4 = *(const f32x4*)(sinT + (size_t)row * 32 + f0);
                    bf16_t* rowp = Z + (size_t)row * 3072 + pn * BM + cin;
#pragma unroll
                    for (int bj = 0; bj < 2; ++bj) { const f32x4 x1 = acc[ai][bj][m][0] * r, x2 = acc[ai][bj][m][1] * r;
                        *(u32x4*)(rowp + bj * HALF) = pack8(x1 * c4 - x2 * s4, x1 * s4 + x2 * c4); } }
        } else if (pn == 12) {
#pragma unroll
            for (int ai = 0; ai < 2; ++ai)
#pragma unroll
                for (int m = 0; m < 4; ++m) { const int row = row0 + ai * HALF + m * 16; const float r = rs[row];
#pragma unroll
                    for (int bj = 0; bj < 2; ++bj)
#pragma unroll
                        for (int n = 0; n < 2; ++n) { const int col = bj * HALF + cin + 4 * n; const f32x4 x = acc[ai][bj][m][n] * r + *(const f32x4*)(ba2 + col); f32x4 o;
#pragma unroll
                            for (int i = 0; i < 4; ++i) o[i] = (fminf(x[i], 0.f) - __logf(1.0f + __expf(-fabsf(x[i])))) * 0.0625f;
                            *(f32x4*)(LA + (size_t)row * 256 + col) = o; } }
        } else {
            const bool act = (pn == 4) | (pn == 5) | (pn == 10) | (pn == 11);
#pragma unroll
            for (int ai = 0; ai < 2; ++ai)
#pragma unroll
                for (int m = 0; m < 4; ++m) { const int row = row0 + ai * HALF + m * 16; const float r = rs[row]; bf16_t* rowp = Z + (size_t)row * 3072 + pn * BM + cin;
#pragma unroll
                    for (int bj = 0; bj < 2; ++bj) { f32x4 v0 = acc[ai][bj][m][0] * r, v1 = acc[ai][bj][m][1] * r; if (act) { v0 = silu4(v0); v1 = silu4(v1); }
                        *(u32x4*)(rowp + bj * HALF) = pack8(v0, v1); } }
        }
    }
};

struct EpiVT {
    static constexpr bool PERM = true, AFTER_DRAIN = false;
    bf16_t* O; int ldc; const float* cs;
    __device__ __forceinline__ void operator()(const f32x4 (&acc)[2][2][4][2], const Unit& u, int wr, int wc, int fr, int fq) const {
        const int row0 = u.pm * BM + wr * 64 + fr, col0 = u.pn * BM + wc * 32 + 8 * fq, p0 = (col0 & ~15) + 4 * (fq & 1);
        f32x4 s[2][2];
#pragma unroll
        for (int bj = 0; bj < 2; ++bj) { s[bj][0] = *(const f32x4*)(cs + col0 + bj * HALF); s[bj][1] = *(const f32x4*)(cs + col0 + bj * HALF + 4); }
#pragma unroll
        for (int ai = 0; ai < 2; ++ai)
#pragma unroll
            for (int m = 0; m < 4; ++m) { bf16_t* rowp = O + (size_t)(row0 + ai * HALF + m * 16) * ldc + p0;
#pragma unroll
                for (int bj = 0; bj < 2; ++bj) { const f32x4 v0 = acc[ai][bj][m][0] * s[bj][0], v1 = acc[ai][bj][m][1] * s[bj][1];
                    u32x2 w0, w1; w0.x = cvt_pk_bf16(v0[0], v0[1]); w0.y = cvt_pk_bf16(v0[2], v0[3]); w1.x = cvt_pk_bf16(v1[0], v1[1]); w1.y = cvt_pk_bf16(v1[2], v1[3]);
                    *(u32x2*)(rowp + bj * HALF) = w0; *(u32x2*)(rowp + bj * HALF + 8) = w1; } }
    }
};
template <class Epi, class Sched, bool ALIGN_EPI = false, bool SP2 = false>
__device__ __forceinline__ void gemm_phase(PG8_LAS unsigned char* lds, const Gemm g, const Sched& S, const Epi& E) {
    int tid_ = threadIdx.x; asm volatile("" : "+v"(tid_));
    const int tid = tid_, wid = __builtin_amdgcn_readfirstlane(tid >> 6), lane = tid & 63, wr = wid >> 2, wc = wid & 3, fr = lane & 15, fq = lane >> 4;
    const int K = g.K, nt = K / BK;
    unsigned voffA[2], voffB[2];
#pragma unroll
    for (int i = 0; i < 2; ++i) { int R, C; stage_rc(tid * 16 + i * 8192, R, C); const int Rb = Epi::PERM ? ((R & ~31) + perm32(R & 31)) : R;
        voffA[i] = (unsigned)(R * K + C) * 2u; voffB[i] = (unsigned)(Rb * K + C) * 2u; }
    const size_t kstep = (size_t)(BK * 2);
    const size_t hstep = (size_t)HALF * K * 2;
    const size_t tstep = 2 * hstep;
    const unsigned ldsw = (unsigned)wid * 1024u;
    const int aoff = lds_byte(wr * 64 + fr, fq * 8), boff = lds_byte(wc * 32 + fr, fq * 8);
#define PG8_SA(b, h) (((b) * 2 + (h)) * HTB)
#define PG8_SB(b, h) ((4 + (b) * 2 + (h)) * HTB)
#define PG8_STAGE(bufoff, gbase, voff) do { _Pragma("unroll") for (int _i = 0; _i < 2; ++_i) \
        __builtin_amdgcn_global_load_lds((const unsigned*)((const char*)(gbase) + (voff)[_i]), (PG8_LAS unsigned*)(lds + (bufoff) + ldsw + _i * 8192), 16, 0, 0); } while (0)
#define PG8_LDA(dst, b, h) do { _Pragma("unroll") for (int m = 0; m < 4; ++m) _Pragma("unroll") for (int k = 0; k < 2; ++k) dst[m][k] = *(const PG8_LAS bf16x8*)(lds + PG8_SA(b, h) + aoff + m * 2048 + k * 1024); } while (0)
#define PG8_LDB(dst, b, h) do { _Pragma("unroll") for (int n = 0; n < 2; ++n) _Pragma("unroll") for (int k = 0; k < 2; ++k) dst[n][k] = *(const PG8_LAS bf16x8*)(lds + PG8_SB(b, h) + boff + n * 2048 + k * 1024); } while (0)
#define PG8_MMA(ai, bj, At, Bt) do { __builtin_amdgcn_s_setprio(1); _Pragma("unroll") for (int m = 0; m < 4; ++m) _Pragma("unroll") for (int n = 0; n < 2; ++n) _Pragma("unroll") for (int k = 0; k < 2; ++k) \
        acc[ai][bj][m][n] = __builtin_amdgcn_mfma_f32_16x16x32_bf16(Bt[n][k], At[m][k], acc[ai][bj][m][n], 0, 0, 0); __builtin_amdgcn_s_setprio(0); } while (0)
#define PG8_WAIT_V(n) asm volatile("s_waitcnt vmcnt(" #n ")" ::: "memory")
#define PG8_WAIT_L(n) asm volatile("s_waitcnt lgkmcnt(" #n ")" ::: "memory")
#define PG8_BAR __builtin_amdgcn_s_barrier()
#define PG8_SCHED __builtin_amdgcn_sched_barrier(0)
    Unit cur, nxt; int ui = 0;
    if (!S.next(0, cur)) return;
    f32x4 acc[2][2][4][2];
#pragma unroll
    for (int a = 0; a < 2; ++a)
#pragma unroll
        for (int b = 0; b < 2; ++b)
#pragma unroll
            for (int m = 0; m < 4; ++m)
#pragma unroll
                for (int n = 0; n < 2; ++n) acc[a][b][m][n] = (f32x4){0.f, 0.f, 0.f, 0.f};
    bf16x8 At[4][2], B0[2][2], B1[2][2];
    const char* cA = (const char*)g.A + (size_t)cur.pm * tstep; const char* cB = (const char*)g.Bt + (size_t)cur.pn * tstep;
    S.a_ready(cur);
    if constexpr (SP2) {
        PG8_STAGE(PG8_SB(0, 0), cB, voffB); PG8_STAGE(PG8_SB(0, 1), cB + hstep, voffB); PG8_STAGE(PG8_SA(0, 0), cA, voffA); PG8_STAGE(PG8_SA(0, 1), cA + hstep, voffA);
        if (wr == 1) PG8_BAR;
        PG8_WAIT_V(2); PG8_BAR;
        PG8_STAGE(PG8_SB(1, 0), cB + kstep, voffB); PG8_STAGE(PG8_SA(1, 0), cA + kstep, voffA); PG8_STAGE(PG8_SB(1, 1), cB + hstep + kstep, voffB);
        PG8_WAIT_V(6); PG8_BAR;
    } else {
        PG8_STAGE(PG8_SB(0, 0), cB, voffB); PG8_STAGE(PG8_SA(0, 0), cA, voffA); PG8_STAGE(PG8_SB(0, 1), cB + hstep, voffB); PG8_STAGE(PG8_SA(0, 1), cA + hstep, voffA);
        if (wr == 1) PG8_BAR;
        PG8_WAIT_V(4); PG8_BAR;
        PG8_STAGE(PG8_SB(1, 0), cB + kstep, voffB); PG8_STAGE(PG8_SA(1, 0), cA + kstep, voffA); PG8_STAGE(PG8_SB(1, 1), cB + hstep + kstep, voffB);
        PG8_WAIT_V(6); PG8_BAR;
    }
    for (;;) {
        const bool has_next = S.next(ui + 1, nxt);
        const char* nA = has_next ? (const char*)g.A + (size_t)nxt.pm * tstep : cA; const char* nB = has_next ? (const char*)g.Bt + (size_t)nxt.pn * tstep : cB;
        for (int t = 0; t < nt; t += 2) {
            const bool last = (t == nt - 2);
            const char* a1 = cA + (size_t)(t + 1) * kstep;
            const char* a2 = last ? nA : cA + (size_t)(t + 2) * kstep; const char* b2 = last ? nB : cB + (size_t)(t + 2) * kstep;
            const char* a3 = a2 + kstep; const char* b3 = b2 + kstep;
            if (last && has_next) S.a_ready(nxt);
            if constexpr (SP2) {
            PG8_LDB(B0, 0, 0); PG8_LDB(B1, 0, 1); PG8_SCHED; PG8_LDA(At, 0, 0); PG8_STAGE(PG8_SA(1, 1), a1 + hstep, voffA);
            PG8_WAIT_V(8); PG8_WAIT_L(0); PG8_BAR; PG8_MMA(0, 0, At, B0); PG8_MMA(0, 1, At, B1); PG8_BAR; PG8_SCHED;
            PG8_LDA(At, 0, 1); PG8_STAGE(PG8_SB(0, 0), b2, voffB); PG8_STAGE(PG8_SB(0, 1), b2 + hstep, voffB); PG8_STAGE(PG8_SA(0, 0), a2, voffA);
            PG8_WAIT_V(8); PG8_WAIT_L(0); PG8_BAR; PG8_MMA(1, 0, At, B0); PG8_MMA(1, 1, At, B1); PG8_BAR; PG8_SCHED;
            PG8_LDB(B0, 1, 0); PG8_LDB(B1, 1, 1); PG8_SCHED; PG8_LDA(At, 1, 0); PG8_STAGE(PG8_SA(0, 1), a2 + hstep, voffA);
            PG8_WAIT_V(8); PG8_WAIT_L(0); PG8_BAR; PG8_MMA(0, 0, At, B0); PG8_MMA(0, 1, At, B1); PG8_BAR; PG8_SCHED;
            PG8_LDA(At, 1, 1); PG8_STAGE(PG8_SB(1, 0), b3, voffB); PG8_STAGE(PG8_SB(1, 1), b3 + hstep, voffB); PG8_STAGE(PG8_SA(1, 0), a3, voffA);
            PG8_WAIT_V(8); PG8_WAIT_L(0); PG8_BAR; PG8_MMA(1, 0, At, B0); PG8_MMA(1, 1, At, B1); PG8_BAR; PG8_SCHED;
            } else {
            PG8_LDB(B0, 0, 0); PG8_SCHED; PG8_LDA(At, 0, 0); PG8_STAGE(PG8_SA(1, 1), a1 + hstep, voffA);
            PG8_WAIT_L(8); PG8_BAR; PG8_WAIT_L(0); PG8_MMA(0, 0, At, B0); PG8_BAR; PG8_SCHED;
            PG8_LDB(B1, 0, 1); PG8_STAGE(PG8_SB(0, 0), b2, voffB);
            PG8_BAR; PG8_WAIT_L(0); PG8_MMA(0, 1, At, B1); PG8_BAR;
            PG8_LDA(At, 0, 1); PG8_STAGE(PG8_SA(0, 0), a2, voffA);
            PG8_BAR; PG8_WAIT_L(0); PG8_MMA(1, 0, At, B0); PG8_BAR; PG8_SCHED;
            PG8_STAGE(PG8_SB(0, 1), b2 + hstep, voffB);
            PG8_WAIT_V(6); PG8_BAR; PG8_MMA(1, 1, At, B1); PG8_BAR;
            PG8_LDB(B0, 1, 0); PG8_SCHED; PG8_LDA(At, 1, 0); PG8_STAGE(PG8_SA(0, 1), a2 + hstep, voffA);
            PG8_WAIT_L(8); PG8_BAR; PG8_WAIT_L(0); PG8_MMA(0, 0, At, B0); PG8_BAR; PG8_SCHED;
            PG8_LDB(B1, 1, 1); PG8_STAGE(PG8_SB(1, 0), b3, voffB);
            PG8_BAR; PG8_WAIT_L(0); PG8_MMA(0, 1, At, B1); PG8_BAR;
            PG8_LDA(At, 1, 1); PG8_STAGE(PG8_SA(1, 0), a3, voffA);
            PG8_BAR; PG8_WAIT_L(0); PG8_MMA(1, 0, At, B0); PG8_BAR; PG8_SCHED;
            PG8_STAGE(PG8_SB(1, 1), b3 + hstep, voffB);
            PG8_WAIT_V(6); PG8_BAR; PG8_MMA(1, 1, At, B1); PG8_BAR;
            }
        }
        if constexpr (ALIGN_EPI) { if (wr == 0) PG8_BAR; }
        if constexpr (!Epi::AFTER_DRAIN) { E(acc, cur, wr, wc, fr, fq); S.done(cur); }
        if (!has_next) break;
#pragma unroll
        for (int a = 0; a < 2; ++a)
#pragma unroll
            for (int b = 0; b < 2; ++b)
#pragma unroll
                for (int m = 0; m < 4; ++m)
#pragma unroll
                    for (int n = 0; n < 2; ++n) acc[a][b][m][n] = (f32x4){0.f, 0.f, 0.f, 0.f};
        cur = nxt; cA = nA; cB = nB; ++ui;
        if constexpr (ALIGN_EPI) { if (wr == 1) PG8_BAR; }
    }
    PG8_WAIT_V(0);
    if constexpr (!ALIGN_EPI) { if (wr == 0) PG8_BAR; }
    PG8_BAR;
    if constexpr (Epi::AFTER_DRAIN) { E.fused(acc, cur, wr, wc, fr, fq, lds, wid, lane); S.done(cur); }
#undef PG8_SA
#undef PG8_SB
#undef PG8_STAGE
#undef PG8_LDA
#undef PG8_LDB
#undef PG8_MMA
#undef PG8_WAIT_V
#undef PG8_WAIT_L
#undef PG8_BAR
#undef PG8_SCHED
}
}
namespace mx {
#define MXL __attribute__((address_space(3)))
typedef short bf16x8 __attribute__((ext_vector_type(8)));
typedef short s16x4 __attribute__((ext_vector_type(4)));
typedef float f32x16 __attribute__((ext_vector_type(16)));
typedef float f32x4 __attribute__((ext_vector_type(4)));
typedef unsigned u32x2 __attribute__((ext_vector_type(2)));
typedef unsigned u32x4 __attribute__((ext_vector_type(4)));
typedef unsigned short bf16;
typedef float f32x2_t __attribute__((ext_vector_type(2))); typedef __bf16 bf16x2_t __attribute__((ext_vector_type(2)));
typedef short v4i16_t __attribute__((ext_vector_type(4)));
constexpr int SEQ = 2048, DM = 1024, MR = 4096, ZW = 3072;
__device__ __forceinline__ unsigned cvtpk(float lo, float hi) { f32x2_t v = {lo, hi}; bf16x2_t b = __builtin_convertvector(v, bf16x2_t); return __builtin_bit_cast(unsigned, b); }
__device__ __forceinline__ float lo16(unsigned w) { return __builtin_bit_cast(float, w << 16); }
__device__ __forceinline__ float hi16(unsigned w) { return __builtin_bit_cast(float, w & 0xffff0000u); }
__device__ __forceinline__ s16x4 tr4(const MXL unsigned char* p) { return __builtin_bit_cast(s16x4, __builtin_amdgcn_ds_read_tr16_b64_v4i16((MXL v4i16_t*)p)); }
__device__ __forceinline__ bf16x8 cat8(s16x4 a, s16x4 b) { return __builtin_shufflevector(a, b, 0, 1, 2, 3, 4, 5, 6, 7); }
#define MX_MFMA(a, b, c) __builtin_amdgcn_mfma_f32_32x32x16_bf16((a), (b), (c), 0, 0, 0)
#define MX_BAR() do { asm volatile("s_waitcnt lgkmcnt(0)" ::: "memory"); __builtin_amdgcn_s_barrier(); asm volatile("" ::: "memory"); } while (0)
#define MX_VBAR() do { asm volatile("s_waitcnt vmcnt(0) lgkmcnt(0)" ::: "memory"); __builtin_amdgcn_s_barrier(); asm volatile("" ::: "memory"); } while (0)

constexpr int XA_UNIT = 1040, XA_BUF = 64 * XA_UNIT;
__device__ __forceinline__ void xa_stage_half(const bf16* g, size_t pitch, MXL unsigned char* buf, int wave, int lane) {
#pragma unroll
    for (int i = 0; i < 8; ++i) { const int j = wave * 8 + i, row = j + 64 * (lane >> 5);
        __builtin_amdgcn_global_load_lds((const unsigned*)(g + (size_t)row * pitch + (lane & 31) * 8), (MXL unsigned*)(buf + j * XA_UNIT), 16, 0, 0); }
}
__device__ __forceinline__ void xattn_phase(MXL unsigned char* lds, const bf16* Q, const bf16* Kb, const bf16* VTb, bf16* AO, int l, int bx) {
    int tid_ = threadIdx.x; asm volatile("" : "+v"(tid_));
    const int lane = tid_ & 63, wave = __builtin_amdgcn_readfirstlane(tid_ >> 6), r = lane & 31, hh = lane >> 5;
    MXL unsigned char* bufA = lds; MXL unsigned char* bufB = lds + XA_BUF;
    const MXL unsigned char* rdA = bufA + r * XA_UNIT + 16 * hh; const MXL unsigned char* rdB = bufB + r * XA_UNIT + 16 * hh;
    for (int it = 0; it < 2; ++it) {
        const int uid = bx * 2 + it, bh = uid >> 3, qb = uid & 7, b = bh >> 2, h = bh & 3;
        const bf16* Kg = Kb + (size_t)(b * 256) * 2048 + l * 1024 + h * 256;
        const bf16* Vg = VTb + (size_t)(l * 1024 + h * 256) * MR + b * 256;
        const size_t qrow = (size_t)b * SEQ + qb * 256 + wave * 32 + r;
        { int lk = lane; asm volatile("" : "+v"(lk)); xa_stage_half(Kg, 2048, bufA, wave, lk); xa_stage_half(Kg + (size_t)128 * 2048, 2048, bufB, wave, lk); }
        bf16x8 qf[16];
        { const bf16* qp = Q + qrow * DM + h * 256 + 8 * hh;
#pragma unroll
          for (int ks = 0; ks < 16; ++ks) qf[ks] = *(const bf16x8*)(qp + 16 * ks); }
        MX_VBAR();
        f32x16 sacc[8];
#pragma unroll
        for (int jb = 0; jb < 8; ++jb) { const MXL unsigned char* rowp = ((jb < 4) ? rdA : rdB) + (jb & 1) * 32 * XA_UNIT + ((jb & 3) >> 1) * 512; f32x16 acc = {};
#pragma unroll
            for (int ks = 0; ks < 16; ++ks) { const bf16x8 a = *(const MXL bf16x8*)(rowp + 32 * ks); acc = MX_MFMA(a, qf[ks], acc); }
            sacc[jb] = acc; }
        MX_BAR();
        { int lv = lane; asm volatile("" : "+v"(lv)); xa_stage_half(Vg, MR, bufA, wave, lv); xa_stage_half(Vg + (size_t)128 * MR, MR, bufB, wave, lv); }
        float mx_ = -__builtin_inff();
#pragma unroll
        for (int jb = 0; jb < 8; ++jb)
#pragma unroll
            for (int i = 0; i < 16; ++i) mx_ = fmaxf(mx_, sacc[jb][i]);
        mx_ = fmaxf(mx_, __shfl_xor(mx_, 32));
        float sum = 0.f; bf16x8 pf[16];
#pragma unroll
        for (int jb = 0; jb < 8; ++jb) { float p[16];
#pragma unroll
            for (int i = 0; i < 16; ++i) { p[i] = __builtin_amdgcn_exp2f((sacc[jb][i] - mx_) * 1.4426950408889634f); sum += p[i]; }
#pragma unroll
            for (int s = 0; s < 2; ++s) { u32x4 w; w.x = cvtpk(p[8 * s + 0], p[8 * s + 1]); w.y = cvtpk(p[8 * s + 2], p[8 * s + 3]); w.z = cvtpk(p[8 * s + 4], p[8 * s + 5]); w.w = cvtpk(p[8 * s + 6], p[8 * s + 7]);
                pf[2 * jb + s] = __builtin_bit_cast(bf16x8, w); } }
        sum += __shfl_xor(sum, 32);
        const float inv = 1.0f / sum;
        MX_VBAR();
        bf16* orow = AO + qrow * DM + h * 256 + 4 * hh;
#pragma unroll
        for (int db = 0; db < 8; ++db) { const MXL unsigned char* rowp = ((db < 4) ? rdA : rdB) + (db & 1) * 32 * XA_UNIT + ((db & 3) >> 1) * 512; f32x16 acc = {};
#pragma unroll
            for (int g = 0; g < 16; ++g) { const bf16x8 a = *(const MXL bf16x8*)(rowp + 32 * g); acc = MX_MFMA(a, pf[g], acc); }
#pragma unroll
            for (int a4 = 0; a4 < 4; ++a4) { u32x2 w; w.x = cvtpk(acc[4 * a4 + 0] * inv, acc[4 * a4 + 1] * inv); w.y = cvtpk(acc[4 * a4 + 2] * inv, acc[4 * a4 + 3] * inv);
                *(u32x2*)(orow + 32 * db + 8 * a4) = w; } }
        MX_BAR();
    }
}

constexpr int KP_PITCH = 192, VI_PITCH = 320, QK_PITCH = 144;
constexpr int ST_KP = 0, ST_VI = 64 * KP_PITCH, ST_CUM = ST_VI + 64 * VI_PITCH;
__device__ __forceinline__ void state_phase(MXL unsigned char* lds, const bf16* Z, float* LA, bf16* ST, int chain) {
    int tid_ = threadIdx.x; asm volatile("" : "+v"(tid_));
    const int tid = tid_, lane = tid & 63, wave = __builtin_amdgcn_readfirstlane(tid >> 6);
    const int grp = chain >> 6, b = (chain >> 2) & 15, h = chain & 3;
    const int koff = grp ? 1792 + 64 * h : 256 + 64 * h, voff = (grp ? 2048 : 512) + 128 * h;
    const float lg = __logf(1.0f - __builtin_amdgcn_exp2f(-5.0f - (float)h));
    const int tj = tid >> 3, ts = tid & 7;
    const int db = wave & 1, vb = wave >> 1;
    const int li = lane & 15, G = lane >> 4, q4 = li >> 2, p4 = li & 3, hh = lane >> 5, r = lane & 31;
    const MXL unsigned char* kpA = lds + ST_KP + (8 * hh + q4) * KP_PITCH + (32 * db + 16 * (G & 1) + 4 * p4) * 2;
    const MXL unsigned char* viB = lds + ST_VI + (8 * hh + q4) * VI_PITCH + (32 * vb + 16 * (G & 1) + 4 * p4) * 2;
    MXL float* cumL = (MXL float*)(lds + ST_CUM);
    f32x16 S = {};
    bf16* stp = ST + (size_t)chain * 32 * 8192 + (size_t)(32 * vb + r) * 64 + 32 * db + 4 * hh;
    for (int n = 0; n < 32; ++n) {
        const size_t row0 = (size_t)b * SEQ + n * 64;
        const u32x4 kraw = *(const u32x4*)(Z + (row0 + tj) * ZW + koff + 8 * ts);
        const u32x4 v0 = *(const u32x4*)(Z + (row0 + tj) * ZW + voff + 16 * ts), v1 = *(const u32x4*)(Z + (row0 + tj) * ZW + voff + 16 * ts + 8);
        if (grp) { if (wave == 0) {
                float* lap = LA + row0 * 256 + 64 * h + lane; float c = 0.f;
#pragma unroll 16
                for (int j = 0; j < 64; ++j) { c += lap[(size_t)j * 256]; lap[(size_t)j * 256] = c; cumL[j * 64 + lane] = c; } } }
        else { if (tid < 64) {
#pragma unroll 16
                for (int j = 0; j < 64; ++j) cumL[j * 64 + tid] = (float)(j + 1) * lg; } }
        MX_BAR();
        { const MXL float* cj = cumL + tj * 64 + 8 * ts; const MXL float* cl = cumL + 63 * 64 + 8 * ts;
          const f32x4 c0 = *(const MXL f32x4*)cj, c1 = *(const MXL f32x4*)(cj + 4), l0 = *(const MXL f32x4*)cl, l1 = *(const MXL f32x4*)(cl + 4);
          u32x4 w;
          w.x = cvtpk(lo16(kraw.x) * __expf(l0[0] - c0[0]), hi16(kraw.x) * __expf(l0[1] - c0[1])); w.y = cvtpk(lo16(kraw.y) * __expf(l0[2] - c0[2]), hi16(kraw.y) * __expf(l0[3] - c0[3]));
          w.z = cvtpk(lo16(kraw.z) * __expf(l1[0] - c1[0]), hi16(kraw.z) * __expf(l1[1] - c1[1])); w.w = cvtpk(lo16(kraw.w) * __expf(l1[2] - c1[2]), hi16(kraw.w) * __expf(l1[3] - c1[3]));
          *(MXL u32x4*)(lds + ST_KP + tj * KP_PITCH + 16 * ts) = w;
          *(MXL u32x4*)(lds + ST_VI + tj * VI_PITCH + 32 * ts) = v0; *(MXL u32x4*)(lds + ST_VI + tj * VI_PITCH + 32 * ts + 16) = v1; }
        MX_BAR();
#pragma unroll
        for (int a4 = 0; a4 < 4; ++a4) { u32x2 w; w.x = cvtpk(S[4 * a4 + 0], S[4 * a4 + 1]); w.y = cvtpk(S[4 * a4 + 2], S[4 * a4 + 3]); *(u32x2*)(stp + (size_t)n * 8192 + 8 * a4) = w; }
        f32x16 D = {};
#pragma unroll
        for (int ks = 0; ks < 4; ++ks) { const bf16x8 a = cat8(tr4(kpA + (16 * ks) * KP_PITCH), tr4(kpA + (16 * ks + 4) * KP_PITCH));
            const bf16x8 bb = cat8(tr4(viB + (16 * ks) * VI_PITCH), tr4(viB + (16 * ks + 4) * VI_PITCH)); D = MX_MFMA(a, bb, D); }
        { const MXL float* cl = cumL + 63 * 64 + 32 * db + 4 * hh;
#pragma unroll
          for (int a4 = 0; a4 < 4; ++a4) { const f32x4 e = *(const MXL f32x4*)(cl + 8 * a4);
#pragma unroll
            for (int i = 0; i < 4; ++i) S[4 * a4 + i] = S[4 * a4 + i] * __expf(e[i]) + D[4 * a4 + i]; } }
        MX_BAR();
    }
}

constexpr int OP_QI = 0, OP_KI = 64 * QK_PITCH, OP_VI = 2 * 64 * QK_PITCH, OP_PART = OP_VI + 64 * VI_PITCH, OP_BYTES = OP_PART + 1024;
__device__ __forceinline__ void out_phase(MXL unsigned char* lds, const bf16* Z, const float* LA, const bf16* ST, const float* ng_ret, const float* ng_gla, bf16* MO, int bx) {
    int tid_ = threadIdx.x; asm volatile("" : "+v"(tid_));
    const int tid = tid_, lane = tid & 63, wave = __builtin_amdgcn_readfirstlane(tid >> 6);
    const int tj = tid >> 3, ts = tid & 7;
    const int a = wave & 3, c = wave >> 2;
    const int li = lane & 15, G = lane >> 4, q4 = li >> 2, p4 = li & 3, hh = lane >> 5, r = lane & 31;
    const MXL unsigned char* viA = lds + OP_VI + (4 * hh + q4) * VI_PITCH + (32 * a + 16 * (G & 1) + 4 * p4) * 2;
    MXL float* part = (MXL float*)(lds + OP_PART);
    for (int it = 0; it < 16; ++it) {
        const int uid = bx * 16 + it, chain = uid >> 5, n = uid & 31, grp = chain >> 6, b = (chain >> 2) & 15, h = chain & 3;
        const int qoff = grp ? 1536 + 64 * h : 64 * h, koff = grp ? 1792 + 64 * h : 256 + 64 * h, voff = (grp ? 2048 : 512) + 128 * h, goff = (grp ? 2560 : 1024) + 128 * h;
        const float lg = __logf(1.0f - __builtin_amdgcn_exp2f(-5.0f - (float)h));
        const size_t row0 = (size_t)b * SEQ + n * 64;
        { const u32x4 qraw = *(const u32x4*)(Z + (row0 + tj) * ZW + qoff + 8 * ts), kraw = *(const u32x4*)(Z + (row0 + tj) * ZW + koff + 8 * ts);
          const u32x4 v0 = *(const u32x4*)(Z + (row0 + tj) * ZW + voff + 16 * ts), v1 = *(const u32x4*)(Z + (row0 + tj) * ZW + voff + 16 * ts + 8);
          f32x4 c0, c1;
          if (grp) { const float* cp = LA + (row0 + tj) * 256 + 64 * h + 8 * ts; c0 = *(const f32x4*)cp; c1 = *(const f32x4*)(cp + 4); }
          else { const float cc = (float)(tj + 1) * lg; c0 = (f32x4){cc, cc, cc, cc}; c1 = c0; }
          float e[8], ei[8];
#pragma unroll
          for (int i = 0; i < 4; ++i) { e[i] = __expf(c0[i]); e[4 + i] = __expf(c1[i]); ei[i] = __expf(-c0[i]); ei[4 + i] = __expf(-c1[i]); }
          u32x4 wq, wk;
          wq.x = cvtpk(lo16(qraw.x) * e[0], hi16(qraw.x) * e[1]); wq.y = cvtpk(lo16(qraw.y) * e[2], hi16(qraw.y) * e[3]); wq.z = cvtpk(lo16(qraw.z) * e[4], hi16(qraw.z) * e[5]); wq.w = cvtpk(lo16(qraw.w) * e[6], hi16(qraw.w) * e[7]);
          wk.x = cvtpk(lo16(kraw.x) * ei[0], hi16(kraw.x) * ei[1]); wk.y = cvtpk(lo16(kraw.y) * ei[2], hi16(kraw.y) * ei[3]); wk.z = cvtpk(lo16(kraw.z) * ei[4], hi16(kraw.z) * ei[5]); wk.w = cvtpk(lo16(kraw.w) * ei[6], hi16(kraw.w) * ei[7]);
          *(MXL u32x4*)(lds + OP_QI + tj * QK_PITCH + 16 * ts) = wq; *(MXL u32x4*)(lds + OP_KI + tj * QK_PITCH + 16 * ts) = wk;
          *(MXL u32x4*)(lds + OP_VI + tj * VI_PITCH + 32 * ts) = v0; *(MXL u32x4*)(lds + OP_VI + tj * VI_PITCH + 32 * ts + 16) = v1; }
        bf16x8 sf[4];
        { const bf16* sp = ST + ((size_t)chain * 32 + n) * 8192 + (size_t)(32 * a + r) * 64 + 8 * hh;
#pragma unroll
          for (int ks = 0; ks < 4; ++ks) sf[ks] = *(const bf16x8*)(sp + 16 * ks); }
        MX_BAR();
        bf16x8 qf[4];
#pragma unroll
        for (int ks = 0; ks < 4; ++ks) qf[ks] = *(const MXL bf16x8*)(lds + OP_QI + (32 * c + r) * QK_PITCH + 32 * ks + 16 * hh);
        f32x16 o = {};
#pragma unroll
        for (int ks = 0; ks < 4; ++ks) o = MX_MFMA(sf[ks], qf[ks], o);
#pragma unroll
        for (int jb = 0; jb < 2; ++jb) if (jb <= c) {
            f32x16 s = {};
#pragma unroll
            for (int ks = 0; ks < 4; ++ks) { const bf16x8 kf = *(const MXL bf16x8*)(lds + OP_KI + (32 * jb + r) * QK_PITCH + 32 * ks + 16 * hh); s = MX_MFMA(kf, qf[ks], s); }
            if (jb == c) {
#pragma unroll
                for (int i = 0; i < 16; ++i) { const int j = 8 * (i >> 2) + 4 * hh + (i & 3); if (j > r) s[i] = 0.f; } }
#pragma unroll
            for (int s2 = 0; s2 < 2; ++s2) { u32x4 w; w.x = cvtpk(s[8 * s2 + 0], s[8 * s2 + 1]); w.y = cvtpk(s[8 * s2 + 2], s[8 * s2 + 3]); w.z = cvtpk(s[8 * s2 + 4], s[8 * s2 + 5]); w.w = cvtpk(s[8 * s2 + 6], s[8 * s2 + 7]);
                const MXL unsigned char* vp = viA + (32 * jb + 16 * s2) * VI_PITCH;
                const bf16x8 vf = cat8(tr4(vp), tr4(vp + 8 * VI_PITCH)); o = MX_MFMA(vf, __builtin_bit_cast(bf16x8, w), o); } }
        float ss = 0.f;
#pragma unroll
        for (int i = 0; i < 16; ++i) ss += o[i] * o[i];
        ss += __shfl_xor(ss, 32);
        if (hh == 0) part[(c * 4 + a) * 32 + r] = ss;
        MX_BAR();
        const float tot = (part[(c * 4 + 0) * 32 + r] + part[(c * 4 + 1) * 32 + r]) + (part[(c * 4 + 2) * 32 + r] + part[(c * 4 + 3) * 32 + r]);
        const float rs = 1.0f / sqrtf(tot * (1.0f / 128.0f) + 1e-6f);
        { const float* ng = (grp ? ng_gla : ng_ret) + h * 128 + 32 * a + 4 * hh; const size_t orow = row0 + 32 * c + r;
          const bf16* gp = Z + orow * ZW + goff + 32 * a + 4 * hh; bf16* op = MO + orow * DM + grp * 512 + h * 128 + 32 * a + 4 * hh;
#pragma unroll
          for (int a4 = 0; a4 < 4; ++a4) { const u32x2 gw = *(const u32x2*)(gp + 8 * a4); const f32x4 gn = *(const f32x4*)(ng + 8 * a4);
              u32x2 w; w.x = cvtpk(o[4 * a4 + 0] * rs * gn[0] * lo16(gw.x), o[4 * a4 + 1] * rs * gn[1] * hi16(gw.x)); w.y = cvtpk(o[4 * a4 + 2] * rs * gn[2] * lo16(gw.y), o[4 * a4 + 3] * rs * gn[3] * hi16(gw.y));
              *(u32x2*)(op + 8 * a4) = w; } }
        MX_BAR();
    }
}
}
constexpr int NWAVES = 8;
constexpr int DM = 1024, NBATCH = 16, SEQ = 2048, MT = NBATCH * SEQ, DFF = 2816, MEML = 256, MR = NBATCH * MEML, INDIM = 3088, NWIN = 3328, ZW = 3072, DEPTH = 2;
constexpr float EPS = 1e-6f;
constexpr int NPHASE = 2 + 15 * DEPTH;
constexpr size_t MiB = 1u << 20;
constexpr size_t WS_CTL = 0, CTL_ZERO_BYTES = 1 * MiB;
constexpr size_t WS_W = 2 * MiB, W_LSTRIDE = 46 * MiB;
constexpr size_t WO_GU1 = 0, WO_D1 = 11 * MiB, WO_WIN = 16 * MiB + 512 * 1024, WO_OUT = 23 * MiB, WO_Q = 25 * MiB, WO_O = 27 * MiB, WO_GU2 = 29 * MiB, WO_D2 = 40 * MiB;
constexpr size_t WS_WK = 94 * MiB, WS_WV = 98 * MiB;
constexpr size_t WS_COS = 102 * MiB, WS_SIN = 106 * MiB;
constexpr size_t WS_RSX = 110 * MiB, WS_RSM = 110 * MiB + 512 * 1024;
constexpr size_t WS_MEMN = 111 * MiB;
constexpr size_t WS_K = 119 * MiB, WS_VT = 135 * MiB;
constexpr size_t WS_XB = 152 * MiB;
constexpr size_t WS_R1 = 216 * MiB;
constexpr size_t WS_BIG = 280 * MiB;
constexpr size_t WS_LA = WS_BIG + 192 * MiB, WS_END = 512 * MiB;
constexpr int CW_TMO = 0, CW_BAR = 4096;
constexpr int LDS_BYTES = 147456, LDS_MISC = LDS_BYTES - 1024;

#define GAS __attribute__((address_space(1)))
#define LAS __attribute__((address_space(3)))
typedef unsigned short bf16;
typedef unsigned v4u __attribute__((ext_vector_type(4)));
typedef unsigned v2u __attribute__((ext_vector_type(2)));
typedef float f32x4 __attribute__((ext_vector_type(4)));
#define LDS_WAIT() asm volatile("s_waitcnt lgkmcnt(0)" ::: "memory")
#define VM_WAIT() asm volatile("s_waitcnt vmcnt(0)" ::: "memory")
__device__ __forceinline__ unsigned f2bf(float f) { unsigned u = __builtin_bit_cast(unsigned, f); return (u + 0x7fffu + ((u >> 16) & 1u)) >> 16; }
__device__ __forceinline__ unsigned pk2(float lo, float hi) { return f2bf(lo) | (f2bf(hi) << 16); }
__device__ __forceinline__ float bflo(unsigned w) { return __builtin_bit_cast(float, w << 16); }
__device__ __forceinline__ float bfhi(unsigned w) { return __builtin_bit_cast(float, w & 0xffff0000u); }
__device__ __forceinline__ float bf2f(bf16 b) { return __builtin_bit_cast(float, (unsigned)b << 16); }
__device__ __forceinline__ float wave_sum(float v) {
#pragma unroll
    for (int o = 1; o < 64; o <<= 1) v += __shfl_xor(v, o);
    return v;
}

#define XB_TMO      128
#define XB_XCNT(j)  (256  + 64 * (j))
#define XB_XSUB(j)  (1280 + 64 * (j))
#define XB_XGEN(j)  (2304 + 64 * (j))
#define XB_TOP      3328
#define XB_TOPGEN   3392
#define XCD_BAR_WORDS 3456
#define XB_SPIN_CAP (1u << 18)

__device__ __forceinline__ unsigned xb_ld(unsigned* p)              { return __hip_atomic_load(p, __ATOMIC_RELAXED, __HIP_MEMORY_SCOPE_AGENT); }
__device__ __forceinline__ unsigned xb_add(unsigned* p, unsigned v) { return __hip_atomic_fetch_add(p, v, __ATOMIC_RELAXED, __HIP_MEMORY_SCOPE_AGENT); }
__device__ __forceinline__ unsigned xb_xcc_id() { return (unsigned)__builtin_amdgcn_s_getreg((3 << 11) | 20) & 0xFu; }
#define XB_SPIN(cond, bar) do { unsigned _sp = 0; while (cond) { __builtin_amdgcn_s_sleep(1); \
    if ((++_sp & 255u) == 0u) { if (xb_ld(&(bar)[XB_TMO])) break; if (_sp > XB_SPIN_CAP) { atomicAdd(&(bar)[XB_TMO], 1u); break; } } } } while (0)

struct XcdBarrier {
    unsigned* bar; unsigned x;
    volatile LAS unsigned* st;
};

__device__ __forceinline__ XcdBarrier xcd_barrier_post(unsigned* bar, volatile LAS unsigned* st) {
    XcdBarrier b; b.bar = bar; b.x = xb_xcc_id(); b.st = st;
    if (threadIdx.x == 0) (void)xb_add(&bar[XB_XCNT(b.x)], 1u);
    return b;
}
__device__ __forceinline__ void xcd_barrier_complete(unsigned* bar, unsigned x, unsigned& nloc, unsigned& nx) {
    const unsigned G = gridDim.x * gridDim.y * gridDim.z;
    unsigned sum, cnt, mine, sp = 0u;
    for (;;) {
        sum = 0u; cnt = 0u; mine = 0u;
#pragma unroll
        for (unsigned j = 0; j < 16; ++j) { const unsigned c = xb_ld(&bar[XB_XCNT(j)]); sum += c; cnt += (c > 0u) ? 1u : 0u; mine = (j == x) ? c : mine; }
        if (sum == G) break;
        __builtin_amdgcn_s_sleep(1);
        if ((++sp & 255u) == 0u) { if (xb_ld(&bar[XB_TMO])) break; if (sp > XB_SPIN_CAP) { atomicAdd(&bar[XB_TMO], 1u); break; } }
    }
    nloc = mine > 0u ? mine : 1u; nx = cnt > 0u ? cnt : 1u;
}

__device__ __forceinline__ void xcd_barrier(const XcdBarrier& b) {
    asm volatile("s_waitcnt vmcnt(0)" ::: "memory");
    __syncthreads();
    if (threadIdx.x == 0) {
        unsigned* bar = b.bar;
        __builtin_amdgcn_s_waitcnt(0);
        unsigned nloc = b.st[0], nx = b.st[1];
        if (nloc == 0u) { xcd_barrier_complete(bar, b.x, nloc, nx); b.st[0] = nloc; b.st[1] = nx; }
        const unsigned old = xb_add(&bar[XB_XSUB(b.x)], 1u);
        const unsigned gen = old / nloc;
        if (old + 1u == (gen + 1u) * nloc) {
            __builtin_amdgcn_fence(__ATOMIC_RELEASE, "agent");
            asm volatile("s_waitcnt vmcnt(0)" ::: "memory");
            const unsigned og = xb_add(&bar[XB_TOP], 1u);
            const unsigned tg = og / nx;
            if (og + 1u == (tg + 1u) * nx) xb_add(&bar[XB_TOPGEN], 1u);
            else XB_SPIN(xb_ld(&bar[XB_TOPGEN]) == tg, bar);
            __builtin_amdgcn_fence(__ATOMIC_ACQUIRE, "agent");
            xb_add(&bar[XB_XGEN(b.x)], 1u);
            asm volatile("s_waitcnt vmcnt(0)" ::: "memory");
        } else {
            XB_SPIN(xb_ld(&bar[XB_XGEN(b.x)]) == gen, bar);
            __builtin_amdgcn_fence(__ATOMIC_ACQUIRE, "agent");
            asm volatile("s_waitcnt vmcnt(0)" ::: "memory");
        }
    }
    __syncthreads();
}

struct Args { const float* in[27]; float* out; unsigned char* ws; int ph_lo, ph_hi, li, pad; };

struct Sec { const float* W; const float* gk; bf16* Bt; int ldw, col0, ncols, K, mode, row_off; float scale; };
__device__ __forceinline__ int dst_map(int mode, int j) {
    if (mode == 1) { const int hd = j >> 6, o = j & 63, x2 = o >> 5, oo = o & 31; return (hd << 6) + 8 * (oo >> 2) + 4 * x2 + (oo & 3); }
    if (mode == 2) return 256 * (j >> 7) + (j & 127);
    return j;
}
__device__ __forceinline__ void xpose_item(const Sec& s, LAS float* scr, int item, int lane) {
    const int nblk = s.ncols / 32, kb = item / nblk, nb = item % nblk, k0 = 64 * kb, n0 = 32 * nb;
#pragma unroll 8
    for (int i = 0; i < 32; ++i) { const int kk = 2 * i + (lane >> 5), k = k0 + kk; float w = s.W[(size_t)k * s.ldw + s.col0 + n0 + (lane & 31)]; if (s.gk) w *= s.gk[k]; scr[kk * 33 + (lane & 31)] = w * s.scale; }
    LDS_WAIT(); asm volatile("" ::: "memory");
    const int c = lane & 7;
#pragma unroll
    for (int j = 0; j < 4; ++j) { const int n = (lane >> 3) + 8 * j; const LAS float* p = scr + (8 * c) * 33 + n;
        v4u o; o.x = pk2(p[0 * 33], p[1 * 33]); o.y = pk2(p[2 * 33], p[3 * 33]); o.z = pk2(p[4 * 33], p[5 * 33]); o.w = pk2(p[6 * 33], p[7 * 33]);
        *(GAS v4u*)(s.Bt + (size_t)(s.row_off + dst_map(s.mode, n0 + n)) * s.K + k0 + 8 * c) = o; }
    LDS_WAIT(); asm volatile("" ::: "memory");
}
__device__ __forceinline__ void row_cvt(const float* xrow, bf16* orow, float* rs_out, int lane) {
    const GAS f32x4* xr = (const GAS f32x4*)xrow + lane;
    f32x4 v[4]; float s = 0.f;
#pragma unroll
    for (int j = 0; j < 4; ++j) { v[j] = xr[64 * j]; s += (v[j].x * v[j].x + v[j].y * v[j].y) + (v[j].z * v[j].z + v[j].w * v[j].w); }
    s = wave_sum(s);
    GAS v2u* o8 = (GAS v2u*)orow + lane;
#pragma unroll
    for (int j = 0; j < 4; ++j) { v2u w; w.x = pk2(v[j].x, v[j].y); w.y = pk2(v[j].z, v[j].w); o8[64 * j] = w; }
    if (lane == 0) *rs_out = 1.0f / sqrtf(s * (1.0f / DM) + EPS);
}
__device__ __forceinline__ void thin_row(const float* xin, const bf16* yrow, const float* g, float coef, float* xout, bf16* xb, float* rs_out, int lane) {
    const GAS v2u* yr = (const GAS v2u*)yrow + lane;
    f32x4 y[4]; float s = 0.f;
#pragma unroll
    for (int j = 0; j < 4; ++j) { const v2u w = yr[64 * j]; y[j] = (f32x4){bflo(w.x), bfhi(w.x), bflo(w.y), bfhi(w.y)}; s += (y[j].x * y[j].x + y[j].y * y[j].y) + (y[j].z * y[j].z + y[j].w * y[j].w); }
    const float ry = coef / sqrtf(wave_sum(s) * (1.0f / DM) + EPS);
    const GAS f32x4* xr = (const GAS f32x4*)xin + lane; const GAS f32x4* gr = (const GAS f32x4*)g + lane;
    GAS f32x4* xo = (GAS f32x4*)xout + lane; GAS v2u* o8 = (GAS v2u*)xb + lane; float s2 = 0.f;
#pragma unroll
    for (int j = 0; j < 4; ++j) { const f32x4 xn = xr[64 * j] + y[j] * ry * gr[64 * j]; xo[64 * j] = xn; v2u w; w.x = pk2(xn.x, xn.y); w.y = pk2(xn.z, xn.w); o8[64 * j] = w;
        s2 += (xn.x * xn.x + xn.y * xn.y) + (xn.z * xn.z + xn.w * xn.w); }
    s2 = wave_sum(s2);
    if (lane == 0) *rs_out = 1.0f / sqrtf(s2 * (1.0f / DM) + EPS);
}


#define CAS __attribute__((address_space(4)))
__device__ __forceinline__ int opq(int v) { asm volatile("" : "+s"(v)); return v; }
__device__ __forceinline__ const CAS unsigned char* karg_opaque() { const CAS unsigned char* k = (const CAS unsigned char*)__builtin_amdgcn_kernarg_segment_ptr(); asm volatile("" : "+s"(k)); return k; }
#define PIN(i) (*(const float* const CAS*)(karg_opaque() + 8 * (i)))
#define POUT (*(float* const CAS*)(karg_opaque() + 8 * 27))
#define WSP(off) (*(unsigned char* const CAS*)(karg_opaque() + 8 * 28) + (off))
__global__ void __launch_bounds__(NWAVES * 64, 2) mk_fwd(Args args) {
    extern __shared__ __attribute__((aligned(16))) unsigned char lds_raw[];
    LAS unsigned char* lds = (LAS unsigned char*)lds_raw;
    const int wave = __builtin_amdgcn_readfirstlane(threadIdx.x >> 6);
    const int G = gridDim.x, bx = blockIdx.x;
    const int vcu = (G % 8 == 0) ? (bx % 8) * (G / 8) + bx / 8 : bx;

    volatile LAS unsigned* MISC = (volatile LAS unsigned*)(lds + LDS_MISC);
    if (threadIdx.x < 64) ((LAS unsigned*)(lds + LDS_MISC))[threadIdx.x] = 0u;
    __syncthreads();
    XcdBarrier bar = xcd_barrier_post((unsigned*)WSP(WS_CTL) + CW_BAR + args.li * XCD_BAR_WORDS, MISC + 8);
    const int lo = args.ph_lo, hi = args.ph_hi;
#define IN(k) (lo <= (k) && (k) < hi)
#define SEAM(k) do { if (IN(k) && IN((k) + 1)) xcd_barrier(bar); } while (0)
    const int gw = vcu * NWAVES + wave, NGW = G * NWAVES, NT = G * NWAVES * 64;
#define LANE_DECL int lane_ = threadIdx.x & 63; asm volatile("" : "+v"(lane_)); const int lane = lane_
#define rsx ((float*)WSP(WS_RSX))
#define rsm ((float*)WSP(WS_RSM))
#define XB ((bf16*)WSP(WS_XB))
#define R1 ((bf16*)WSP(WS_R1))
#define BIG ((bf16*)WSP(WS_BIG))
#define LA ((float*)WSP(WS_LA))
#define MEMN ((bf16*)WSP(WS_MEMN))
#define KB ((bf16*)WSP(WS_K))
#define VT ((bf16*)WSP(WS_VT))
#define cosT ((float*)WSP(WS_COS))
#define sinT ((float*)WSP(WS_SIN))
    if (IN(0)) {
        LANE_DECL; const int gtid = (vcu * NWAVES * 64) + (int)threadIdx.x;
        LAS float* scr = (LAS float*)(lds + wave * 16384);
        constexpr int C_GU = 16 * 88, C_D = 44 * 32, C_128 = 16 * 4 * 2, C_256 = 16 * 8 * 2, C_SQ = 16 * 32, PER_L = 6 * C_GU   + 4 * C_128 + 4 * C_256 + 5 * C_SQ;
        static_assert(C_GU == C_D && PER_L == 12544, "item counts");
        for (int it = gw; it < DEPTH * PER_L; it += NGW) {
            const int l = it / PER_L; int r = it % PER_L; Sec s; bool found = false;
            const size_t wl = WS_W + (size_t)l * W_LSTRIDE;
            const float* gF1 = PIN(3) + l * DM; const float* gMix = PIN(8) + l * DM; const float* gXa = PIN(16) + l * DM; const float* gMem = PIN(17) + l * DM; const float* gF2 = PIN(22) + l * DM;
            const float* w_in = PIN(9) + (size_t)l * DM * INDIM; const float* w_kv = PIN(19) + (size_t)l * DM * 2048;
#define SEC(cnt, W_, ldw_, col0_, ncols_, K_, gk_, scale_, Bt_, mode_, roff_) if (!found) { if (r < (cnt)) { s.W = (W_); s.ldw = (ldw_); s.col0 = (col0_); s.ncols = (ncols_); s.K = (K_); s.gk = (gk_); s.scale = (scale_); s.Bt = (bf16*)(Bt_); s.mode = (mode_); s.row_off = (roff_); found = true; } else r -= (cnt); }
            SEC(C_GU, PIN(4) + (size_t)l * DM * DFF, DFF, 0, DFF, DM, gF1, 1.f, WSP(wl + WO_GU1), 2, 0)
            SEC(C_GU, PIN(5) + (size_t)l * DM * DFF, DFF, 0, DFF, DM, gF1, 1.f, WSP(wl + WO_GU1), 2, 128)
            SEC(C_D, PIN(6) + (size_t)l * DFF * DM, DM, 0, DM, DFF, nullptr, 1.f, WSP(wl + WO_D1), 0, 0)
            SEC(C_128, w_in, INDIM, 0, 256, DM, gMix, 1.f, WSP(wl + WO_WIN), 1, 0)
            SEC(C_128, w_in, INDIM, 256, 256, DM, gMix, 0.125f, WSP(wl + WO_WIN), 1, 256)
            SEC(C_256, w_in, INDIM, 512, 512, DM, gMix, 1.f, WSP(wl + WO_WIN), 0, 512)
            SEC(C_256, w_in, INDIM, 1024, 512, DM, gMix, 1.f, WSP(wl + WO_WIN), 0, 1024)
            SEC(C_128, w_in, INDIM, 1536, 256, DM, gMix, 0.125f, WSP(wl + WO_WIN), 0, 1536)
            SEC(C_128, w_in, INDIM, 1792, 256, DM, gMix, 1.f, WSP(wl + WO_WIN), 0, 1792)
            SEC(C_256, w_in, INDIM, 2048, 512, DM, gMix, 1.f, WSP(wl + WO_WIN), 0, 2048)
            SEC(C_256, w_in, INDIM, 2576, 512, DM, gMix, 1.f, WSP(wl + WO_WIN), 0, 2560)
            SEC(C_SQ, PIN(14) + (size_t)l * DM * DM, DM, 0, DM, DM, nullptr, 1.f, WSP(wl + WO_OUT), 0, 0)
            SEC(C_SQ, PIN(18) + (size_t)l * DM * DM, DM, 0, DM, DM, gXa, 0.0625f, WSP(wl + WO_Q), 0, 0)
            SEC(C_SQ, PIN(20) + (size_t)l * DM * DM, DM, 0, DM, DM, nullptr, 1.f, WSP(wl + WO_O), 0, 0)
            SEC(C_SQ, w_kv, 2048, 0, DM, DM, gMem, 1.f, WSP(WS_WK), 0, l * DM)
            SEC(C_SQ, w_kv, 2048, DM, DM, DM, gMem, 1.f, WSP(WS_WV), 0, l * DM)
            SEC(C_GU, PIN(23) + (size_t)l * DM * DFF, DFF, 0, DFF, DM, gF2, 1.f, WSP(wl + WO_GU2), 2, 0)
            SEC(C_GU, PIN(24) + (size_t)l * DM * DFF, DFF, 0, DFF, DM, gF2, 1.f, WSP(wl + WO_GU2), 2, 128)
            SEC(C_D, PIN(25) + (size_t)l * DFF * DM, DM, 0, DM, DFF, nullptr, 1.f, WSP(wl + WO_D2), 0, 0)
#undef SEC
            if (found) xpose_item(s, scr, r, lane);
        }
        for (int idx = gtid; idx < DEPTH * 256 * DM; idx += NT) { const int l = idx >> 18, c = (idx >> 10) & 255, k = idx & 1023;
            const float* wi = PIN(9) + (size_t)l * DM * INDIM + (size_t)k * INDIM + 2560; const float* wa = PIN(10) + l * 16 * 256 + c; float s = 0.f;
#pragma unroll
            for (int r = 0; r < 16; ++r) s += wi[r] * wa[r * 256];
            s *= PIN(8)[l * DM + k];
            ((bf16*)WSP(WS_W + (size_t)l * W_LSTRIDE + WO_WIN))[(size_t)(3072 + c) * DM + k] = (bf16)f2bf(s); }
        { const int* pos = (const int*)PIN(2);
          for (int idx = gtid; idx < MT * 32; idx += NT) { const int m = idx >> 5, f = idx & 31;
            double inv = 1.0; if (f & 1) inv *= 0.7498942093324559; if (f & 2) inv *= 0.5623413251903492; if (f & 4) inv *= 0.316227766016838; if (f & 8) inv *= 0.1; if (f & 16) inv *= 0.01;
            const double ang = (double)pos[m] * inv, j = __builtin_rint(ang * 0.6366197723675814);
            const double rr = __builtin_fma(-j, 6.123233995736766e-17, __builtin_fma(-j, 1.5707963267948966, ang)), z = rr * rr;
            const double sn = rr * (1.0 + z * (-1.0 / 6 + z * (1.0 / 120 + z * (-1.0 / 5040 + z * (1.0 / 362880 + z * (-1.0 / 39916800 + z * (1.0 / 6227020800.0)))))));
            const double cs = 1.0 + z * (-0.5 + z * (1.0 / 24 + z * (-1.0 / 720 + z * (1.0 / 40320 + z * (-1.0 / 3628800 + z * (1.0 / 479001600.0))))));
            const int q = (int)j & 3; const double c = (q == 0) ? cs : (q == 1) ? -sn : (q == 2) ? -cs : sn, s = (q == 0) ? sn : (q == 1) ? cs : (q == 2) ? -sn : -cs;
            cosT[idx] = (float)c; sinT[idx] = (float)s; } }
        for (int m = gw; m < MT; m += NGW) row_cvt(PIN(0) + (size_t)m * DM, XB + (size_t)m * DM, rsx + m, lane);
        for (int m = gw; m < MR; m += NGW) row_cvt(PIN(1) + (size_t)m * DM, MEMN + (size_t)m * DM, rsm + m, lane);
        __syncthreads();
    }
    SEAM(0);
    if (IN(1)) {
        if (bx < 128) { pg8::Gemm g{MEMN, (const bf16*)WSP(WS_WK), MR, 2048, DM}; pg8::StaticOrder S; S.init(MR, 2048, 128, bx);
            pg8::EpiRowScale E{KB, 2048, rsm}; pg8::gemm_phase<pg8::EpiRowScale, pg8::StaticOrder, false, true>(lds, g, S, E); }
        else { pg8::Gemm g{(const bf16*)WSP(WS_WV), MEMN, 2048, MR, DM}; pg8::StaticOrder S; S.init(2048, MR, 128, bx - 128);
            pg8::EpiVT E{VT, MR, rsm}; pg8::gemm_phase<pg8::EpiVT, pg8::StaticOrder, false, true>(lds, g, S, E); }
    }
    SEAM(1);
    for (int l = 0; l < DEPTH; ++l) {
        const int pb = 2 + 15 * l;
        const size_t wl = WS_W + (size_t)l * W_LSTRIDE;
        const float* xin = (l == 0) ? PIN(0) : POUT;
        if (IN(pb + 0)) { pg8::Gemm g{XB, (const bf16*)WSP(wl + WO_GU1), MT, 2 * DFF, DM}; pg8::StaticOrder S; S.init(MT, 2 * DFF, opq(G), opq(bx));
            pg8::EpiGU E{BIG, DFF, rsx}; pg8::gemm_phase<pg8::EpiGU, pg8::StaticOrder, true, true>(lds, g, S, E); }
        SEAM(pb + 0);
        if (IN(pb + 1)) { pg8::Gemm g{BIG, (const bf16*)WSP(wl + WO_D1), MT, DM, DFF}; pg8::StaticOrder S; S.init(MT, DM, opq(G), opq(bx));
            pg8::EpiPlain E{R1, DM}; pg8::gemm_phase<pg8::EpiPlain, pg8::StaticOrder, true, true>(lds, g, S, E); }
        SEAM(pb + 1);
        if (IN(pb + 2)) { LANE_DECL; const float* gp = PIN(7) + l * DM;
            for (int m = gw; m < MT; m += NGW) thin_row(xin + (size_t)m * DM, R1 + (size_t)m * DM, gp, 0.5f, POUT + (size_t)m * DM, XB + (size_t)m * DM, rsx + m, lane); }
        SEAM(pb + 2);
        if (IN(pb + 3)) { pg8::Gemm g{XB, (const bf16*)WSP(wl + WO_WIN), MT, NWIN, DM}; pg8::StaticOrder S; S.init(MT, NWIN, opq(G), opq(bx));
            pg8::EpiWin E{BIG, LA, rsx, cosT, sinT, PIN(11) + l * 256}; pg8::gemm_phase<pg8::EpiWin, pg8::StaticOrder, true, true>(lds, g, S, E); }
        SEAM(pb + 3);
        if (IN(pb + 4)) { if (bx < 128) mx::state_phase(lds, BIG, LA, XB, opq(bx)); }
        SEAM(pb + 4);
        if (IN(pb + 5)) { mx::out_phase(lds, BIG, LA, XB, PIN(12) + l * 512, PIN(13) + l * 512, R1, opq(bx)); }
        SEAM(pb + 5);
        if (IN(pb + 6)) { pg8::Gemm g{R1, (const bf16*)WSP(wl + WO_OUT), MT, DM, DM}; pg8::StaticOrder S; S.init(MT, DM, opq(G), opq(bx));
            pg8::EpiPlain E{BIG, DM}; pg8::gemm_phase<pg8::EpiPlain, pg8::StaticOrder, true, true>(lds, g, S, E); }
        SEAM(pb + 6);
        if (IN(pb + 7)) { LANE_DECL; const float* gp = PIN(15) + l * DM;
            for (int m = gw; m < MT; m += NGW) thin_row(POUT + (size_t)m * DM, BIG + (size_t)m * DM, gp, 1.0f, POUT + (size_t)m * DM, XB + (size_t)m * DM, rsx + m, lane); }
        SEAM(pb + 7);
        if (IN(pb + 8)) { pg8::Gemm g{XB, (const bf16*)WSP(wl + WO_Q), MT, DM, DM}; pg8::StaticOrder S; S.init(MT, DM, opq(G), opq(bx));
            pg8::EpiRowScale E{BIG, DM, rsx}; pg8::gemm_phase<pg8::EpiRowScale, pg8::StaticOrder, true, true>(lds, g, S, E); }
        SEAM(pb + 8);
        if (IN(pb + 9)) { mx::xattn_phase(lds, BIG, KB, VT, BIG + (size_t)MT * DM, l, opq(bx)); }
        SEAM(pb + 9);
        if (IN(pb + 10)) { pg8::Gemm g{BIG + (size_t)MT * DM, (const bf16*)WSP(wl + WO_O), MT, DM, DM}; pg8::StaticOrder S; S.init(MT, DM, opq(G), opq(bx));
            pg8::EpiPlain E{R1, DM}; pg8::gemm_phase<pg8::EpiPlain, pg8::StaticOrder, true, true>(lds, g, S, E); }
        SEAM(pb + 10);
        if (IN(pb + 11)) { LANE_DECL; const float* gp = PIN(21) + l * DM;
            for (int m = gw; m < MT; m += NGW) thin_row(POUT + (size_t)m * DM, R1 + (size_t)m * DM, gp, 1.0f, POUT + (size_t)m * DM, XB + (size_t)m * DM, rsx + m, lane); }
        SEAM(pb + 11);
        if (IN(pb + 12)) { pg8::Gemm g{XB, (const bf16*)WSP(wl + WO_GU2), MT, 2 * DFF, DM}; pg8::StaticOrder S; S.init(MT, 2 * DFF, opq(G), opq(bx));
            pg8::EpiGU E{BIG, DFF, rsx}; pg8::gemm_phase<pg8::EpiGU, pg8::StaticOrder, true, true>(lds, g, S, E); }
        SEAM(pb + 12);
        if (IN(pb + 13)) { pg8::Gemm g{BIG, (const bf16*)WSP(wl + WO_D2), MT, DM, DFF}; pg8::StaticOrder S; S.init(MT, DM, opq(G), opq(bx));
            pg8::EpiPlain E{R1, DM}; pg8::gemm_phase<pg8::EpiPlain, pg8::StaticOrder, true, true>(lds, g, S, E); }
        SEAM(pb + 13);
        if (IN(pb + 14)) { LANE_DECL; const float* gp = PIN(26) + l * DM;
            for (int m = gw; m < MT; m += NGW) thin_row(POUT + (size_t)m * DM, R1 + (size_t)m * DM, gp, 0.5f, POUT + (size_t)m * DM, XB + (size_t)m * DM, rsx + m, lane); }
        SEAM(pb + 14);
    }
#undef IN
#undef SEAM
#undef rsx
#undef rsm
#undef XB
#undef R1
#undef BIG
#undef LA
#undef MEMN
#undef KB
#undef VT
#undef cosT
#undef sinT
}

__global__ void __launch_bounds__(128) naive_mixer(const bf16* Z, const float* LA, const float* ng_ret, const float* ng_gla, bf16* MO) {
    const int blk = blockIdx.x, grp = blk >> 6, b = (blk >> 2) & 15, h = blk & 3, dv = threadIdx.x;
    const int qoff = grp ? 1536 + 64 * h : 64 * h, koff = grp ? 1792 + 64 * h : 256 + 64 * h, voff = (grp ? 2048 : 512) + 128 * h, goff = (grp ? 2560 : 1024) + 128 * h;
    const float* ng = grp ? ng_gla : ng_ret;
    __shared__ float qs[64], ks[64], as[64], red[2];
    float S[64];
#pragma unroll
    for (int d = 0; d < 64; ++d) S[d] = 0.f;
    const float gamma = 1.0f - exp2f(-5.0f - (float)h);
    for (int t = 0; t < SEQ; ++t) {
        const size_t row = (size_t)b * SEQ + t;
        if (dv < 64) { qs[dv] = bf2f(Z[row * ZW + qoff + dv]); ks[dv] = bf2f(Z[row * ZW + koff + dv]); as[dv] = grp ? expf(LA[row * 256 + 64 * h + dv]) : gamma; }
        __syncthreads();
        const float v = bf2f(Z[row * ZW + voff + dv]); float o = 0.f;
#pragma unroll
        for (int d = 0; d < 64; ++d) { S[d] = as[d] * S[d] + ks[d] * v; o += qs[d] * S[d]; }
        const float ss = wave_sum(o * o);
        if ((dv & 63) == 0) red[dv >> 6] = ss;
        __syncthreads();
        const float r = 1.0f / sqrtf((red[0] + red[1]) * (1.0f / 128.0f) + EPS);
        MO[row * DM + grp * 512 + h * 128 + dv] = (bf16)f2bf(o * r * ng[h * 128 + dv] * bf2f(Z[row * ZW + goff + dv]));
        __syncthreads();
    }
}
__global__ void __launch_bounds__(256) naive_xattn(const bf16* Q, const bf16* KB, const bf16* VT, bf16* AO, int l) {
    const int h = blockIdx.x & 3, r0 = (blockIdx.x >> 2) * 4, b = r0 / SEQ, j = threadIdx.x;
    __shared__ float qs[4][256], ps[4][256], red[4][4];
    for (int i = 0; i < 4; ++i) qs[i][j] = bf2f(Q[(size_t)(r0 + i) * DM + h * 256 + j]);
    __syncthreads();
    const bf16* kr = KB + (size_t)(b * 256 + j) * 2048 + l * 1024 + h * 256;
    float s[4] = {0.f, 0.f, 0.f, 0.f};
    for (int d = 0; d < 256; ++d) { const float kv = bf2f(kr[d]);
#pragma unroll
        for (int i = 0; i < 4; ++i) s[i] += qs[i][d] * kv; }
    for (int i = 0; i < 4; ++i) { float m = s[i];
        for (int o = 1; o < 64; o <<= 1) m = fmaxf(m, __shfl_xor(m, o));
        if ((j & 63) == 0) red[i][j >> 6] = m; }
    __syncthreads();
    float e[4];
    for (int i = 0; i < 4; ++i) { const float m = fmaxf(fmaxf(red[i][0], red[i][1]), fmaxf(red[i][2], red[i][3])); e[i] = expf(s[i] - m); }
    __syncthreads();
    for (int i = 0; i < 4; ++i) { const float t = wave_sum(e[i]); if ((j & 63) == 0) red[i][j >> 6] = t; }
    __syncthreads();
    for (int i = 0; i < 4; ++i) ps[i][j] = e[i] / ((red[i][0] + red[i][1]) + (red[i][2] + red[i][3]));
    __syncthreads();
    const bf16* vr = VT + (size_t)(l * 1024 + h * 256 + j) * MR + b * 256;
    float o[4] = {0.f, 0.f, 0.f, 0.f};
    for (int k = 0; k < 256; ++k) { const float vv = bf2f(vr[k]);
#pragma unroll
        for (int i = 0; i < 4; ++i) o[i] += ps[i][k] * vv; }
    for (int i = 0; i < 4; ++i) AO[(size_t)(r0 + i) * DM + h * 256 + j] = (bf16)f2bf(o[i]);
}

extern "C" void kernel_launch(void* const* d_in, const int* in_sizes, int n_in, void* d_out, int out_size, void* d_ws, size_t ws_size, hipStream_t stream) {
    static int grid = 0;
    if (grid == 0) {
        if (n_in != 27 || out_size != MT * DM || ws_size < WS_END) { fprintf(stderr, "kernel_launch: unexpected shapes (n_in %d out %d ws %zu)\n", n_in, out_size, ws_size); grid = -1; return; }
        if (hipFuncSetAttribute((const void*)mk_fwd, hipFuncAttributeMaxDynamicSharedMemorySize, LDS_BYTES) != hipSuccess) { fprintf(stderr, "kernel_launch: hipFuncSetAttribute failed\n"); grid = -1; return; }
        int dev = 0, cus = 0; (void)hipGetDevice(&dev); (void)hipDeviceGetAttribute(&cus, hipDeviceAttributeMultiprocessorCount, dev);
        int per_cu = 0; (void)hipOccupancyMaxActiveBlocksPerMultiprocessor(&per_cu, (const void*)mk_fwd, NWAVES * 64, LDS_BYTES); (void)hipGetLastError();
        if (cus < 256 || per_cu < 1) fprintf(stderr, "kernel_launch: note: %d CUs, occupancy %d\n", cus, per_cu);
        grid = 256;
    }
    if (grid < 0) return;
    (void)hipMemsetAsync((char*)d_ws + WS_CTL, 0, CTL_ZERO_BYTES, stream);
    Args a{};
    for (int i = 0; i < 27; ++i) a.in[i] = (const float*)d_in[i];
    a.out = (float*)d_out; a.ws = (unsigned char*)d_ws; a.pad = 0;
    unsigned char* ws = (unsigned char*)d_ws;
    int li = 0;
    auto run = [&](int lo, int hi) { a.ph_lo = lo; a.ph_hi = hi; a.li = li++; hipLaunchKernelGGL(mk_fwd, dim3(grid), dim3(NWAVES * 64), LDS_BYTES, stream, a); };
#if MK_ONE_LAUNCH
    run(0, NPHASE);
#else
    run(0, 1); run(1, 2);
    for (int l = 0; l < DEPTH; ++l) { const int pb = 2 + 15 * l;
        run(pb + 0, pb + 1); run(pb + 1, pb + 2); run(pb + 2, pb + 3); run(pb + 3, pb + 4);
#if FAST_MIXER
        run(pb + 4, pb + 5); run(pb + 5, pb + 6);
#else
        hipLaunchKernelGGL(naive_mixer, dim3(128), dim3(128), 0, stream, (const bf16*)(ws + WS_BIG), (const float*)(ws + WS_LA), (const float*)d_in[12] + l * 512, (const float*)d_in[13] + l * 512, (bf16*)(ws + WS_R1));
#endif
        run(pb + 6, pb + 7); run(pb + 7, pb + 8); run(pb + 8, pb + 9);
#if FAST_XATTN
        run(pb + 9, pb + 10);
#else
        hipLaunchKernelGGL(naive_xattn, dim3(MT), dim3(256), 0, stream, (const bf16*)(ws + WS_BIG), (const bf16*)(ws + WS_K), (const bf16*)(ws + WS_VT), (bf16*)(ws + WS_BIG) + (size_t)MT * DM, l);
#endif
        run(pb + 10, pb + 11); run(pb + 11, pb + 12); run(pb + 12, pb + 13); run(pb + 13, pb + 14); run(pb + 14, pb + 15);
    }
#endif
}
```

```cpp
#include <hip/hip_runtime.h>
#include <cstdio>
#include <cstdint>
#ifndef MK_ONE_LAUNCH
#define MK_ONE_LAUNCH 1
#endif
#define MK_DBL 0
#ifndef FAST_MIXER
#define FAST_MIXER 1
#endif
#ifndef FAST_XATTN
#define FAST_XATTN 1
#endif
namespace pg8 {
#define PG8_LAS __attribute__((address_space(3)))
typedef unsigned short bf16_t;
typedef short bf16x8 __attribute__((ext_vector_type(8)));
typedef float f32x4 __attribute__((ext_vector_type(4)));
typedef unsigned u32x4 __attribute__((ext_vector_type(4)));
constexpr int BM = 256, BK = 64, HALF = 128, HTB = HALF * BK * 2  , STAGE_BYTES = 8 * HTB, NXCD = 8, WGM = 8;

__host__ __device__ __forceinline__ int lds_byte(int r, int c) { const int st = (r >> 4) * 2 + (c >> 5), rr = r & 15, cc = c & 31, ob = rr * 64 + cc * 2; return st * 1024 + (ob ^ (((ob >> 9) & 1) << 5)); }
__host__ __device__ __forceinline__ void stage_rc(int b, int& R, int& C) { const int st = b / 1024, sb = b % 1024, swz = sb ^ (((sb >> 9) & 1) << 5); R = (st >> 1) * 16 + swz / 64; C = (st & 1) * 32 + (swz % 64) / 2; }
__host__ __device__ __forceinline__ int perm32(int rho) { const int n = rho >> 4, i = rho & 15; return 8 * (i >> 2) + 4 * n + (i & 3); }

struct Unit { int pm, pn; };
struct Gemm { const bf16_t* A; const bf16_t* Bt; int M, N, K; };

struct StaticOrder {
    int nM, nN, nwg, G, c;
    __host__ __device__ void init(int M, int N, int G_, int c_) { nM = M / BM; nN = N / BM; nwg = nM * nN; G = G_; c = c_; }
    __host__ __device__ bool next(int i, Unit& u) const {
        const long L = (long)i * G + c; if (L >= nwg) return false;
        int wgid = (int)L; { const int q = nwg / NXCD, r = nwg % NXCD, xcd = wgid % NXCD, off = wgid / NXCD; wgid = (xcd < r ? xcd * (q + 1) : r * (q + 1) + (xcd - r) * q) + off; }
        const int nig = WGM * nN, gid = wgid / nig, fm = gid * WGM, gsz = (nM - fm) < WGM ? (nM - fm) : WGM;
        u.pm = fm + ((wgid % nig) % gsz); u.pn = (wgid % nig) / gsz; return true;
    }
    __device__ __forceinline__ void a_ready(const Unit&) const {}
    __device__ __forceinline__ void done(const Unit&) const {}
};

__device__ __forceinline__ unsigned cvt_pk_bf16(float lo, float hi) { unsigned r; asm volatile("v_cvt_pk_bf16_f32 %0, %1, %2" : "=v"(r) : "v"(lo), "v"(hi)); return r; }
constexpr float RMS_EPS = 1e-6f;
typedef unsigned u32x2 __attribute__((ext_vector_type(2)));
__device__ __forceinline__ float sigmoid_f(float x) { return __builtin_amdgcn_rcpf(1.0f + __expf(-x)); }
__device__ __forceinline__ f32x4 silu4(f32x4 v) { f32x4 o; o[0] = v[0] * sigmoid_f(v[0]); o[1] = v[1] * sigmoid_f(v[1]); o[2] = v[2] * sigmoid_f(v[2]); o[3] = v[3] * sigmoid_f(v[3]); return o; }
__device__ __forceinline__ u32x4 pack8(f32x4 v0, f32x4 v1) { u32x4 w; w.x = cvt_pk_bf16(v0[0], v0[1]); w.y = cvt_pk_bf16(v0[2], v0[3]); w.z = cvt_pk_bf16(v1[0], v1[1]); w.w = cvt_pk_bf16(v1[2], v1[3]); return w; }

struct EpiPlain {
    static constexpr bool PERM = true, AFTER_DRAIN = false;
    bf16_t* O; int ldc;
    __device__ __forceinline__ void operator()(const f32x4 (&acc)[2][2][4][2], const Unit& u, int wr, int wc, int fr, int fq) const {
        const int row0 = u.pm * BM + wr * 64 + fr, col0 = u.pn * BM + wc * 32 + 8 * fq;
#pragma unroll
        for (int ai = 0; ai < 2; ++ai)
#pragma unroll
            for (int m = 0; m < 4; ++m) { bf16_t* rowp = O + (size_t)(row0 + ai * HALF + m * 16) * ldc + col0;
#pragma unroll
                for (int bj = 0; bj < 2; ++bj) *(u32x4*)(rowp + bj * HALF) = pack8(acc[ai][bj][m][0], acc[ai][bj][m][1]); }
    }
};
struct EpiRowScale {
    static constexpr bool PERM = true, AFTER_DRAIN = false;
    bf16_t* O; int ldc; const float* rs;
    __device__ __forceinline__ void operator()(const f32x4 (&acc)[2][2][4][2], const Unit& u, int wr, int wc, int fr, int fq) const {
        const int row0 = u.pm * BM + wr * 64 + fr, col0 = u.pn * BM + wc * 32 + 8 * fq;
#pragma unroll
        for (int ai = 0; ai < 2; ++ai)
#pragma unroll
            for (int m = 0; m < 4; ++m) { const int row = row0 + ai * HALF + m * 16; const float r = rs[row]; bf16_t* rowp = O + (size_t)row * ldc + col0;
#pragma unroll
                for (int bj = 0; bj < 2; ++bj) *(u32x4*)(rowp + bj * HALF) = pack8(acc[ai][bj][m][0] * r, acc[ai][bj][m][1] * r); }
    }
};
struct EpiColScale {
    static constexpr bool PERM = true, AFTER_DRAIN = false;
    bf16_t* O; int ldc; const float* cs;
    __device__ __forceinline__ void operator()(const f32x4 (&acc)[2][2][4][2], const Unit& u, int wr, int wc, int fr, int fq) const {
        const int row0 = u.pm * BM + wr * 64 + fr, col0 = u.pn * BM + wc * 32 + 8 * fq;
        f32x4 s[2][2];
#pragma unroll
        for (int bj = 0; bj < 2; ++bj) { s[bj][0] = *(const f32x4*)(cs + col0 + bj * HALF); s[bj][1] = *(const f32x4*)(cs + col0 + bj * HALF + 4); }
#pragma unroll
        for (int ai = 0; ai < 2; ++ai)
#pragma unroll
            for (int m = 0; m < 4; ++m) { bf16_t* rowp = O + (size_t)(row0 + ai * HALF + m * 16) * ldc + col0;
#pragma unroll
                for (int bj = 0; bj < 2; ++bj) *(u32x4*)(rowp + bj * HALF) = pack8(acc[ai][bj][m][0] * s[bj][0], acc[ai][bj][m][1] * s[bj][1]); }
    }
};
struct EpiGU {
    static constexpr bool PERM = true, AFTER_DRAIN = false;
    bf16_t* H; int ldh; const float* rs;
    __device__ __forceinline__ void operator()(const f32x4 (&acc)[2][2][4][2], const Unit& u, int wr, int wc, int fr, int fq) const {
        const int row0 = u.pm * BM + wr * 64 + fr, col0 = u.pn * HALF + wc * 32 + 8 * fq;
#pragma unroll
        for (int ai = 0; ai < 2; ++ai)
#pragma unroll
            for (int m = 0; m < 4; ++m) { const int row = row0 + ai * HALF + m * 16; const float r = rs[row];
                const f32x4 h0 = silu4(acc[ai][0][m][0] * r) * (acc[ai][1][m][0] * r), h1 = silu4(acc[ai][0][m][1] * r) * (acc[ai][1][m][1] * r);
                *(u32x4*)(H + (size_t)row * ldh + col0) = pack8(h0, h1); }
    }
};
struct EpiWin {
    static constexpr bool PERM = true, AFTER_DRAIN = false;
    bf16_t* Z; float* LA; const float* rs; const float* cosT; const float* sinT; const float* ba2;
    __device__ __forceinline__ void operator()(const f32x4 (&acc)[2][2][4][2], const Unit& u, int wr, int wc, int fr, int fq) const {
        const int row0 = u.pm * BM + wr * 64 + fr, cin = wc * 32 + 8 * fq, pn = u.pn;
        if (pn <= 1) {
            const int f0 = 16 * (wc & 1) + 4 * fq;
#pragma unroll
            for (int ai = 0; ai < 2; ++ai)
#pragma unroll
                for (int m = 0; m < 4; ++m) { const int row = row0 + ai * HALF + m * 16; const float r = rs[row];
                    const f32x4 c4 = *(const f32x4*)(cosT + (size_t)row * 32 + f0), s4 = *(const f32x4*)(sinT + (size_t)row * 32 + f0);
                    bf16_t* rowp = Z + (size_t)row * 3072 + pn * BM + cin;
#pragma unroll
                    for (int bj = 0; bj < 2; ++bj) { const f32x4 x1 = acc[ai][bj][m][0] * r, x2 = acc[ai][bj][m][1] * r;
                        *(u32x4*)(rowp + bj * HALF) = pack8(x1 * c4 - x2 * s4, x1 * s4 + x2 * c4); } }
        } else if (pn == 12) {
#pragma unroll
            for (int ai = 0; ai < 2; ++ai)
#pragma unroll
                for (int m = 0; m < 4; ++m) { const int row = row0 + ai * HALF + m * 16; const float r = rs[row];
#pragma unroll
                    for (int bj = 0; bj < 2; ++bj)
#pragma unroll
                        for (int n = 0; n < 2; ++n) { const int col = bj * HALF + cin + 4 * n; const f32x4 x = acc[ai][bj][m][n] * r + *(const f32x4*)(ba2 + col); f32x4 o;
#pragma unroll
                            for (int i = 0; i < 4; ++i) o[i] = (fminf(x[i], 0.f) - __logf(1.0f + __expf(-fabsf(x[i])))) * 0.0625f;
                            *(f32x4*)(LA + (size_t)row * 256 + col) = o; } }
        } else {
            const bool act = (pn == 4) | (pn == 5) | (pn == 10) | (pn == 11);
#pragma unroll
            for (int ai = 0; ai < 2; ++ai)
#pragma unroll
                for (int m = 0; m < 4; ++m) { const int row = row0 + ai * HALF + m * 16; const float r = rs[row]; bf16_t* rowp = Z + (size_t)row * 3072 + pn * BM + cin;
#pragma unroll
                    for (int bj = 0; bj < 2; ++bj) { f32x4 v0 = acc[ai][bj][m][0] * r, v1 = acc[ai][bj][m][1] * r; if (act) { v0 = silu4(v0); v1 = silu4(v1); }
                        *(u32x4*)(rowp + bj * HALF) = pack8(v0, v1); } }
        }
    }
};

struct EpiVT {
    static constexpr bool PERM = true, AFTER_DRAIN = false;
    bf16_t* O; int ldc; const float* cs;
    __device__ __forceinline__ void operator()(const f32x4 (&acc)[2][2][4][2], const Unit& u, int wr, int wc, int fr, int fq) const {
        const int row0 = u.pm * BM + wr * 64 + fr, col0 = u.pn * BM + wc * 32 + 8 * fq, p0 = (col0 & ~15) + 4 * (fq & 1);
        f32x4 s[2][2];
#pragma unroll
        for (int bj = 0; bj < 2; ++bj) { s[bj][0] = *(const f32x4*)(cs + col0 + bj * HALF); s[bj][1] = *(const f32x4*)(cs + col0 + bj * HALF + 4); }
#pragma unroll
        for (int ai = 0; ai < 2; ++ai)
#pragma unroll
            for (int m = 0; m < 4; ++m) { bf16_t* rowp = O + (size_t)(row0 + ai * HALF + m * 16) * ldc + p0;
#pragma unroll
                for (int bj = 0; bj < 2; ++bj) { const f32x4 v0 = acc[ai][bj][m][0] * s[bj][0], v1 = acc[ai][bj][m][1] * s[bj][1];
                    u32x2 w0, w1; w0.x = cvt_pk_bf16(v0[0], v0[1]); w0.y = cvt_pk_bf16(v0[2], v0[3]); w1.x = cvt_pk_bf16(v1[0], v1[1]); w1.y = cvt_pk_bf16(v1[2], v1[3]);
                    *(u32x2*)(rowp + bj * HALF) = w0; *(u32x2*)(rowp + bj * HALF + 8) = w1; } }
    }
};
template <class Epi, class Sched, bool ALIGN_EPI = false, bool SP2 = false>
__device__ __forceinline__ void gemm_phase(PG8_LAS unsigned char* lds, const Gemm g, const Sched& S, const Epi& E) {
    int tid_ = threadIdx.x; asm volatile("" : "+v"(tid_));
    const int tid = tid_, wid = __builtin_amdgcn_readfirstlane(tid >> 6), lane = tid & 63, wr = wid >> 2, wc = wid & 3, fr = lane & 15, fq = lane >> 4;
    const int K = g.K, nt = K / BK;
    unsigned voffA[2], voffB[2];
#pragma unroll
    for (int i = 0; i < 2; ++i) { int R, C; stage_rc(tid * 16 + i * 8192, R, C); const int Rb = Epi::PERM ? ((R & ~31) + perm32(R & 31)) : R;
        voffA[i] = (unsigned)(R * K + C) * 2u; voffB[i] = (unsigned)(Rb * K + C) * 2u; }
    const size_t kstep = (size_t)(BK * 2);
    const size_t hstep = (size_t)HALF * K * 2;
    const size_t tstep = 2 * hstep;
    const unsigned ldsw = (unsigned)wid * 1024u;
    const int aoff = lds_byte(wr * 64 + fr, fq * 8), boff = lds_byte(wc * 32 + fr, fq * 8);
#define PG8_SA(b, h) (((b) * 2 + (h)) * HTB)
#define PG8_SB(b, h) ((4 + (b) * 2 + (h)) * HTB)
#define PG8_STAGE(bufoff, gbase, voff) do { _Pragma("unroll") for (int _i = 0; _i < 2; ++_i) \
        __builtin_amdgcn_global_load_lds((const unsigned*)((const char*)(gbase) + (voff)[_i]), (PG8_LAS unsigned*)(lds + (bufoff) + ldsw + _i * 8192), 16, 0, 0); } while (0)
#define PG8_LDA(dst, b, h) do { _Pragma("unroll") for (int m = 0; m < 4; ++m) _Pragma("unroll") for (int k = 0; k < 2; ++k) dst[m][k] = *(const PG8_LAS bf16x8*)(lds + PG8_SA(b, h) + aoff + m * 2048 + k * 1024); } while (0)
#define PG8_LDB(dst, b, h) do { _Pragma("unroll") for (int n = 0; n < 2; ++n) _Pragma("unroll") for (int k = 0; k < 2; ++k) dst[n][k] = *(const PG8_LAS bf16x8*)(lds + PG8_SB(b, h) + boff + n * 2048 + k * 1024); } while (0)
#define PG8_MMA(ai, bj, At, Bt) do { __builtin_amdgcn_s_setprio(1); _Pragma("unroll") for (int m = 0; m < 4; ++m) _Pragma("unroll") for (int n = 0; n < 2; ++n) _Pragma("unroll") for (int k = 0; k < 2; ++k) \
        acc[ai][bj][m][n] = __builtin_amdgcn_mfma_f32_16x16x32_bf16(Bt[n][k], At[m][k], acc[ai][bj][m][n], 0, 0, 0); __builtin_amdgcn_s_setprio(0); } while (0)
#define PG8_WAIT_V(n) asm volatile("s_waitcnt vmcnt(" #n ")" ::: "memory")
#define PG8_WAIT_L(n) asm volatile("s_waitcnt lgkmcnt(" #n ")" ::: "memory")
#define PG8_BAR __builtin_amdgcn_s_barrier()
#define PG8_SCHED __builtin_amdgcn_sched_barrier(0)
    Unit cur, nxt; int ui = 0;
    if (!S.next(0, cur)) return;
    f32x4 acc[2][2][4][2];
#pragma unroll
    for (int a = 0; a < 2; ++a)
#pragma unroll
        for (int b = 0; b < 2; ++b)
#pragma unroll
            for (int m = 0; m < 4; ++m)
#pragma unroll
                for (int n = 0; n < 2; ++n) acc[a][b][m][n] = (f32x4){0.f, 0.f, 0.f, 0.f};
    bf16x8 At[4][2], B0[2][2], B1[2][2];
    const char* cA = (const char*)g.A + (size_t)cur.pm * tstep; const char* cB = (const char*)g.Bt + (size_t)cur.pn * tstep;
    S.a_ready(cur);
    if constexpr (SP2) {
        PG8_STAGE(PG8_SB(0, 0), cB, voffB); PG8_STAGE(PG8_SB(0, 1), cB + hstep, voffB); PG8_STAGE(PG8_SA(0, 0), cA, voffA); PG8_STAGE(PG8_SA(0, 1), cA + hstep, voffA);
        if (wr == 1) PG8_BAR;
        PG8_WAIT_V(2); PG8_BAR;
        PG8_STAGE(PG8_SB(1, 0), cB + kstep, voffB); PG8_STAGE(PG8_SA(1, 0), cA + kstep, voffA); PG8_STAGE(PG8_SB(1, 1), cB + hstep + kstep, voffB);
        PG8_WAIT_V(6); PG8_BAR;
    } else {
        PG8_STAGE(PG8_SB(0, 0), cB, voffB); PG8_STAGE(PG8_SA(0, 0), cA, voffA); PG8_STAGE(PG8_SB(0, 1), cB + hstep, voffB); PG8_STAGE(PG8_SA(0, 1), cA + hstep, voffA);
        if (wr == 1) PG8_BAR;
        PG8_WAIT_V(4); PG8_BAR;
        PG8_STAGE(PG8_SB(1, 0), cB + kstep, voffB); PG8_STAGE(PG8_SA(1, 0), cA + kstep, voffA); PG8_STAGE(PG8_SB(1, 1), cB + hstep + kstep, voffB);
        PG8_WAIT_V(6); PG8_BAR;
    }
    for (;;) {
        const bool has_next = S.next(ui + 1, nxt);
        const char* nA = has_next ? (const char*)g.A + (size_t)nxt.pm * tstep : cA; const char* nB = has_next ? (const char*)g.Bt + (size_t)nxt.pn * tstep : cB;
        for (int t = 0; t < nt; t += 2) {
            const bool last = (t == nt - 2);
            const char* a1 = cA + (size_t)(t + 1) * kstep;
            const char* a2 = last ? nA : cA + (size_t)(t + 2) * kstep; const char* b2 = last ? nB : cB + (size_t)(t + 2) * kstep;
            const char* a3 = a2 + kstep; const char* b3 = b2 + kstep;
            if (last && has_next) S.a_ready(nxt);
            if constexpr (SP2) {
            PG8_LDB(B0, 0, 0); PG8_LDB(B1, 0, 1); PG8_SCHED; PG8_LDA(At, 0, 0); PG8_STAGE(PG8_SA(1, 1), a1 + hstep, voffA);
            PG8_WAIT_V(8); PG8_WAIT_L(0); PG8_BAR; PG8_MMA(0, 0, At, B0); PG8_MMA(0, 1, At, B1); PG8_BAR; PG8_SCHED;
            PG8_LDA(At, 0, 1); PG8_STAGE(PG8_SB(0, 0), b2, voffB); PG8_STAGE(PG8_SB(0, 1), b2 + hstep, voffB); PG8_STAGE(PG8_SA(0, 0), a2, voffA);
            PG8_WAIT_V(8); PG8_WAIT_L(0); PG8_BAR; PG8_MMA(1, 0, At, B0); PG8_MMA(1, 1, At, B1); PG8_BAR; PG8_SCHED;
            PG8_LDB(B0, 1, 0); PG8_LDB(B1, 1, 1); PG8_SCHED; PG8_LDA(At, 1, 0); PG8_STAGE(PG8_SA(0, 1), a2 + hstep, voffA);
            PG8_WAIT_V(8); PG8_WAIT_L(0); PG8_BAR; PG8_MMA(0, 0, At, B0); PG8_MMA(0, 1, At, B1); PG8_BAR; PG8_SCHED;
            PG8_LDA(At, 1, 1); PG8_STAGE(PG8_SB(1, 0), b3, voffB); PG8_STAGE(PG8_SB(1, 1), b3 + hstep, voffB); PG8_STAGE(PG8_SA(1, 0), a3, voffA);
            PG8_WAIT_V(8); PG8_WAIT_L(0); PG8_BAR; PG8_MMA(1, 0, At, B0); PG8_MMA(1, 1, At, B1); PG8_BAR; PG8_SCHED;
            } else {
            PG8_LDB(B0, 0, 0); PG8_SCHED; PG8_LDA(At, 0, 0); PG8_STAGE(PG8_SA(1, 1), a1 + hstep, voffA);
            PG8_WAIT_L(8); PG8_BAR; PG8_WAIT_L(0); PG8_MMA(0, 0, At, B0); PG8_BAR; PG8_SCHED;
            PG8_LDB(B1, 0, 1); PG8_STAGE(PG8_SB(0, 0), b2, voffB);
            PG8_BAR; PG8_WAIT_L(0); PG8_MMA(0, 1, At, B1); PG8_BAR;
            PG8_LDA(At, 0, 1); PG8_STAGE(PG8_SA(0, 0), a2, voffA);
            PG8_BAR; PG8_WAIT_L(0); PG8_MMA(1, 0, At, B0); PG8_BAR; PG8_SCHED;
            PG8_STAGE(PG8_SB(0, 1), b2 + hstep, voffB);
            PG8_WAIT_V(6); PG8_BAR; PG8_MMA(1, 1, At, B1); PG8_BAR;
            PG8_LDB(B0, 1, 0); PG8_SCHED; PG8_LDA(At, 1, 0); PG8_STAGE(PG8_SA(0, 1), a2 + hstep, voffA);
            PG8_WAIT_L(8); PG8_BAR; PG8_WAIT_L(0); PG8_MMA(0, 0, At, B0); PG8_BAR; PG8_SCHED;
            PG8_LDB(B1, 1, 1); PG8_STAGE(PG8_SB(1, 0), b3, voffB);
            PG8_BAR; PG8_WAIT_L(0); PG8_MMA(0, 1, At, B1); PG8_BAR;
            PG8_LDA(At, 1, 1); PG8_STAGE(PG8_SA(1, 0), a3, voffA);
            PG8_BAR; PG8_WAIT_L(0); PG8_MMA(1, 0, At, B0); PG8_BAR; PG8_SCHED;
            PG8_STAGE(PG8_SB(1, 1), b3 + hstep, voffB);
            PG8_WAIT_V(6); PG8_BAR; PG8_MMA(1, 1, At, B1); PG8_BAR;
            }
        }
        if constexpr (ALIGN_EPI) { if (wr == 0) PG8_BAR; }
        if constexpr (!Epi::AFTER_DRAIN) { E(acc, cur, wr, wc, fr, fq); S.done(cur); }
        if (!has_next) break;
#pragma unroll
        for (int a = 0; a < 2; ++a)
#pragma unroll
            for (int b = 0; b < 2; ++b)
#pragma unroll
                for (int m = 0; m < 4; ++m)
#pragma unroll
                    for (int n = 0; n < 2; ++n) acc[a][b][m][n] = (f32x4){0.f, 0.f, 0.f, 0.f};
        cur = nxt; cA = nA; cB = nB; ++ui;
        if constexpr (ALIGN_EPI) { if (wr == 1) PG8_BAR; }
    }
    PG8_WAIT_V(0);
    if constexpr (!ALIGN_EPI) { if (wr == 0) PG8_BAR; }
    PG8_BAR;
    if constexpr (Epi::AFTER_DRAIN) { E.fused(acc, cur, wr, wc, fr, fq, lds, wid, lane); S.done(cur); }
#undef PG8_SA
#undef PG8_SB
#undef PG8_STAGE
#undef PG8_LDA
#undef PG8_LDB
#undef PG8_MMA
#undef PG8_WAIT_V
#undef PG8_WAIT_L
#undef PG8_BAR
#undef PG8_SCHED
}
}
namespace mx {
#define MXL __attribute__((address_space(3)))
typedef short bf16x8 __attribute__((ext_vector_type(8)));
typedef short s16x4 __attribute__((ext_vector_type(4)));
typedef float f32x16 __attribute__((ext_vector_type(16)));
typedef float f32x4 __attribute__((ext_vector_type(4)));
typedef unsigned u32x2 __attribute__((ext_vector_type(2)));
typedef unsigned u32x4 __attribute__((ext_vector_type(4)));
typedef unsigned short bf16;
typedef float f32x2_t __attribute__((ext_vector_type(2))); typedef __bf16 bf16x2_t __attribute__((ext_vector_type(2)));
typedef short v4i16_t __attribute__((ext_vector_type(4)));
constexpr int SEQ = 2048, DM = 1024, MR = 4096, ZW = 3072;
__device__ __forceinline__ unsigned cvtpk(float lo, float hi) { f32x2_t v = {lo, hi}; bf16x2_t b = __builtin_convertvector(v, bf16x2_t); return __builtin_bit_cast(unsigned, b); }
__device__ __forceinline__ float lo16(unsigned w) { return __builtin_bit_cast(float, w << 16); }
__device__ __forceinline__ float hi16(unsigned w) { return __builtin_bit_cast(float, w & 0xffff0000u); }
__device__ __forceinline__ s16x4 tr4(const MXL unsigned char* p) { return __builtin_bit_cast(s16x4, __builtin_amdgcn_ds_read_tr16_b64_v4i16((MXL v4i16_t*)p)); }
__device__ __forceinline__ bf16x8 cat8(s16x4 a, s16x4 b) { return __builtin_shufflevector(a, b, 0, 1, 2, 3, 4, 5, 6, 7); }
#define MX_MFMA(a, b, c) __builtin_amdgcn_mfma_f32_32x32x16_bf16((a), (b), (c), 0, 0, 0)
#define MX_BAR() do { asm volatile("s_waitcnt lgkmcnt(0)" ::: "memory"); __builtin_amdgcn_s_barrier(); asm volatile("" ::: "memory"); } while (0)
#define MX_VBAR() do { asm volatile("s_waitcnt vmcnt(0) lgkmcnt(0)" ::: "memory"); __builtin_amdgcn_s_barrier(); asm volatile("" ::: "memory"); } while (0)

constexpr int XA_UNIT = 1040, XA_BUF = 64 * XA_UNIT;
__device__ __forceinline__ void xa_stage_half(const bf16* g, size_t pitch, MXL unsigned char* buf, int wave, int lane) {
#pragma unroll
    for (int i = 0; i < 8; ++i) { const int j = wave * 8 + i, row = j + 64 * (lane >> 5);
        __builtin_amdgcn_global_load_lds((const unsigned*)(g + (size_t)row * pitch + (lane & 31) * 8), (MXL unsigned*)(buf + j * XA_UNIT), 16, 0, 0); }
}
__device__ __forceinline__ void xattn_phase(MXL unsigned char* lds, const bf16* Q, const bf16* Kb, const bf16* VTb, bf16* AO, int l, int bx) {
    int tid_ = threadIdx.x; asm volatile("" : "+v"(tid_));
    const int lane = tid_ & 63, wave = __builtin_amdgcn_readfirstlane(tid_ >> 6), r = lane & 31, hh = lane >> 5;
    MXL unsigned char* bufA = lds; MXL unsigned char* bufB = lds + XA_BUF;
    const MXL unsigned char* rdA = bufA + r * XA_UNIT + 16 * hh; const MXL unsigned char* rdB = bufB + r * XA_UNIT + 16 * hh;
    for (int it = 0; it < 2; ++it) {
        const int uid = bx * 2 + it, bh = uid >> 3, qb = uid & 7, b = bh >> 2, h = bh & 3;
        const bf16* Kg = Kb + (size_t)(b * 256) * 2048 + l * 1024 + h * 256;
        const bf16* Vg = VTb + (size_t)(l * 1024 + h * 256) * MR + b * 256;
        const size_t qrow = (size_t)b * SEQ + qb * 256 + wave * 32 + r;
        { int lk = lane; asm volatile("" : "+v"(lk)); xa_stage_half(Kg, 2048, bufA, wave, lk); xa_stage_half(Kg + (size_t)128 * 2048, 2048, bufB, wave, lk); }
        bf16x8 qf[16];
        { const bf16* qp = Q + qrow * DM + h * 256 + 8 * hh;
#pragma unroll
          for (int ks = 0; ks < 16; ++ks) qf[ks] = *(const bf16x8*)(qp + 16 * ks); }
        MX_VBAR();
        f32x16 sacc[8];
#pragma unroll
        for (int jb = 0; jb < 8; ++jb) { const MXL unsigned char* rowp = ((jb < 4) ? rdA : rdB) + (jb & 1) * 32 * XA_UNIT + ((jb & 3) >> 1) * 512; f32x16 acc = {};
#pragma unroll
            for (int ks = 0; ks < 16; ++ks) { const bf16x8 a = *(const MXL bf16x8*)(rowp + 32 * ks); acc = MX_MFMA(a, qf[ks], acc); }
            sacc[jb] = acc; }
        MX_BAR();
        { int lv = lane; asm volatile("" : "+v"(lv)); xa_stage_half(Vg, MR, bufA, wave, lv); xa_stage_half(Vg + (size_t)128 * MR, MR, bufB, wave, lv); }
        float mx_ = -__builtin_inff();
#pragma unroll
        for (int jb = 0; jb < 8; ++jb)
#pragma unroll
            for (int i = 0; i < 16; ++i) mx_ = fmaxf(mx_, sacc[jb][i]);
        mx_ = fmaxf(mx_, __shfl_xor(mx_, 32));
        float sum = 0.f; bf16x8 pf[16];
#pragma unroll
        for (int jb = 0; jb < 8; ++jb) { float p[16];
#pragma unroll
            for (int i = 0; i < 16; ++i) { p[i] = __builtin_amdgcn_exp2f((sacc[jb][i] - mx_) * 1.4426950408889634f); sum += p[i]; }
#pragma unroll
            for (int s = 0; s < 2; ++s) { u32x4 w; w.x = cvtpk(p[8 * s + 0], p[8 * s + 1]); w.y = cvtpk(p[8 * s + 2], p[8 * s + 3]); w.z = cvtpk(p[8 * s + 4], p[8 * s + 5]); w.w = cvtpk(p[8 * s + 6], p[8 * s + 7]);
                pf[2 * jb + s] = __builtin_bit_cast(bf16x8, w); } }
        sum += __shfl_xor(sum, 32);
        const float inv = 1.0f / sum;
        MX_VBAR();
        bf16* orow = AO + qrow * DM + h * 256 + 4 * hh;
#pragma unroll
        for (int db = 0; db < 8; ++db) { const MXL unsigned char* rowp = ((db < 4) ? rdA : rdB) + (db & 1) * 32 * XA_UNIT + ((db & 3) >> 1) * 512; f32x16 acc = {};
#pragma unroll
            for (int g = 0; g < 16; ++g) { const bf16x8 a = *(const MXL bf16x8*)(rowp + 32 * g); acc = MX_MFMA(a, pf[g], acc); }
#pragma unroll
            for (int a4 = 0; a4 < 4; ++a4) { u32x2 w; w.x = cvtpk(acc[4 * a4 + 0] * inv, acc[4 * a4 + 1] * inv); w.y = cvtpk(acc[4 * a4 + 2] * inv, acc[4 * a4 + 3] * inv);
                *(u32x2*)(orow + 32 * db + 8 * a4) = w; } }
        MX_BAR();
    }
}

constexpr int KP_PITCH = 192, VI_PITCH = 320, QK_PITCH = 144;
constexpr int ST_KP = 0, ST_VI = 64 * KP_PITCH, ST_CUM = ST_VI + 64 * VI_PITCH;
__device__ __forceinline__ void ukv_phase(MXL unsigned char* lds, const bf16* Z, float* LA, bf16* U, float* EL, int bx) {
    int tid_ = threadIdx.x; asm volatile("" : "+v"(tid_));
    const int tid = tid_, lane = tid & 63, wave = __builtin_amdgcn_readfirstlane(tid >> 6);
    const int tj = tid >> 3, ts = tid & 7;
    const int db = wave & 1, vb = wave >> 1;
    const int li = lane & 15, G = lane >> 4, q4 = li >> 2, p4 = li & 3, hh = lane >> 5, r = lane & 31;
    const MXL unsigned char* kpA = lds + ST_KP + (8 * hh + q4) * KP_PITCH + (32 * db + 16 * (G & 1) + 4 * p4) * 2;
    const MXL unsigned char* viB = lds + ST_VI + (8 * hh + q4) * VI_PITCH + (32 * vb + 16 * (G & 1) + 4 * p4) * 2;
    MXL float* wtot = (MXL float*)(lds + ST_CUM);
    for (int it = 0; it < 16; ++it) {
        const int uid = bx * 16 + it, chain = uid >> 5, n = uid & 31, grp = chain >> 6, b = (chain >> 2) & 15, h = chain & 3;
        const int koff = grp ? 1792 + 64 * h : 256 + 64 * h, voff = (grp ? 2048 : 512) + 128 * h;
        const size_t row0 = (size_t)b * SEQ + n * 64;
        const u32x4 kraw = *(const u32x4*)(Z + (row0 + tj) * ZW + koff + 8 * ts);
        const u32x4 v0 = *(const u32x4*)(Z + (row0 + tj) * ZW + voff + 16 * ts), v1 = *(const u32x4*)(Z + (row0 + tj) * ZW + voff + 16 * ts + 8);
        float cv[8], lv[8];
        if (grp) {
            float* lap = LA + (row0 + tj) * 256 + 64 * h + 8 * ts;
            { const f32x4 a0 = *(const f32x4*)lap, a1 = *(const f32x4*)(lap + 4);
#pragma unroll
              for (int i = 0; i < 4; ++i) { cv[i] = a0[i]; cv[4 + i] = a1[i]; } }
#pragma unroll
            for (int off = 8; off < 64; off <<= 1)
#pragma unroll
                for (int i = 0; i < 8; ++i) { const float t = __shfl_up(cv[i], off); if (lane >= off) cv[i] += t; }
            if (lane >= 56) {
#pragma unroll
                for (int i = 0; i < 8; ++i) wtot[wave * 64 + 8 * ts + i] = cv[i]; }
            MX_BAR();
            float pv[8];
#pragma unroll
            for (int i = 0; i < 8; ++i) { pv[i] = 0.f; lv[i] = 0.f; }
#pragma unroll
            for (int w = 0; w < 8; ++w) { const f32x4 a0 = *(const MXL f32x4*)(wtot + w * 64 + 8 * ts), a1 = *(const MXL f32x4*)(wtot + w * 64 + 8 * ts + 4);
#pragma unroll
                for (int i = 0; i < 4; ++i) { lv[i] += a0[i]; lv[4 + i] += a1[i]; if (w < wave) { pv[i] += a0[i]; pv[4 + i] += a1[i]; } } }
#pragma unroll
            for (int i = 0; i < 8; ++i) cv[i] += pv[i];
            *(f32x4*)lap = (f32x4){cv[0], cv[1], cv[2], cv[3]}; *(f32x4*)(lap + 4) = (f32x4){cv[4], cv[5], cv[6], cv[7]};
            if (tj == 0) { float* ep = EL + (size_t)uid * 64 + 8 * ts; *(f32x4*)ep = (f32x4){__expf(lv[0]), __expf(lv[1]), __expf(lv[2]), __expf(lv[3])}; *(f32x4*)(ep + 4) = (f32x4){__expf(lv[4]), __expf(lv[5]), __expf(lv[6]), __expf(lv[7])}; }
        } else {
            const float lg = __logf(1.0f - __builtin_amdgcn_exp2f(-5.0f - (float)h));
#pragma unroll
            for (int i = 0; i < 8; ++i) { cv[i] = (float)(tj + 1) * lg; lv[i] = 64.0f * lg; }
        }
        { u32x4 w;
          w.x = cvtpk(lo16(kraw.x) * __expf(lv[0] - cv[0]), hi16(kraw.x) * __expf(lv[1] - cv[1])); w.y = cvtpk(lo16(kraw.y) * __expf(lv[2] - cv[2]), hi16(kraw.y) * __expf(lv[3] - cv[3]));
          w.z = cvtpk(lo16(kraw.z) * __expf(lv[4] - cv[4]), hi16(kraw.z) * __expf(lv[5] - cv[5])); w.w = cvtpk(lo16(kraw.w) * __expf(lv[6] - cv[6]), hi16(kraw.w) * __expf(lv[7] - cv[7]));
          *(MXL u32x4*)(lds + ST_KP + tj * KP_PITCH + 16 * ts) = w;
          *(MXL u32x4*)(lds + ST_VI + tj * VI_PITCH + 32 * ts) = v0; *(MXL u32x4*)(lds + ST_VI + tj * VI_PITCH + 32 * ts + 16) = v1; }
        MX_BAR();
        f32x16 D = {};
#pragma unroll
        for (int ks = 0; ks < 4; ++ks) { const bf16x8 a = cat8(tr4(kpA + (16 * ks) * KP_PITCH), tr4(kpA + (16 * ks + 4) * KP_PITCH));
            const bf16x8 bb = cat8(tr4(viB + (16 * ks) * VI_PITCH), tr4(viB + (16 * ks + 4) * VI_PITCH)); D = MX_MFMA(a, bb, D); }
        { bf16* up = U + (size_t)uid * 8192 + (size_t)(32 * vb + r) * 64 + 32 * db + 4 * hh;
#pragma unroll
          for (int a4 = 0; a4 < 4; ++a4) { u32x2 w; w.x = cvtpk(D[4 * a4 + 0], D[4 * a4 + 1]); w.y = cvtpk(D[4 * a4 + 2], D[4 * a4 + 3]); *(u32x2*)(up + 8 * a4) = w; } }
        MX_BAR();
    }
}
__device__ __forceinline__ void scan_phase(const bf16* U, const float* EL, bf16* ST, int gtid, int nthreads) {
    for (int item = gtid; item < 131072; item += nthreads) {
        const int chain = item >> 10, rem = item & 1023, ds = item & 7, grp = chain >> 6, h = chain & 3;
        const float eg = __expf(64.0f * __logf(1.0f - __builtin_amdgcn_exp2f(-5.0f - (float)h)));
        float S[8];
#pragma unroll
        for (int i = 0; i < 8; ++i) S[i] = 0.f;
#pragma unroll 4
        for (int n = 0; n < 32; ++n) { const size_t unit = (size_t)chain * 32 + n, off = unit * 8192 + (size_t)rem * 8;
            const u32x4 u = *(const u32x4*)(U + off); f32x4 e0, e1;
            if (grp) { e0 = *(const f32x4*)(EL + unit * 64 + 8 * ds); e1 = *(const f32x4*)(EL + unit * 64 + 8 * ds + 4); } else { e0 = (f32x4){eg, eg, eg, eg}; e1 = e0; }
            u32x4 w; w.x = cvtpk(S[0], S[1]); w.y = cvtpk(S[2], S[3]); w.z = cvtpk(S[4], S[5]); w.w = cvtpk(S[6], S[7]);
            *(u32x4*)(ST + off) = w;
            S[0] = e0[0] * S[0] + lo16(u.x); S[1] = e0[1] * S[1] + hi16(u.x); S[2] = e0[2] * S[2] + lo16(u.y); S[3] = e0[3] * S[3] + hi16(u.y);
            S[4] = e1[0] * S[4] + lo16(u.z); S[5] = e1[1] * S[5] + hi16(u.z); S[6] = e1[2] * S[6] + lo16(u.w); S[7] = e1[3] * S[7] + hi16(u.w); }
    }
}

constexpr int OP_QI = 0, OP_KI = 64 * QK_PITCH, OP_VI = 2 * 64 * QK_PITCH, OP_PART = OP_VI + 64 * VI_PITCH, OP_BYTES = OP_PART + 1024;
__device__ __forceinline__ void out_phase(MXL unsigned char* lds, const bf16* Z, const float* LA, const bf16* ST, const float* ng_ret, const float* ng_gla, bf16* MO, int bx) {
    int tid_ = threadIdx.x; asm volatile("" : "+v"(tid_));
    const int tid = tid_, lane = tid & 63, wave = __builtin_amdgcn_readfirstlane(tid >> 6);
    const int tj = tid >> 3, ts = tid & 7;
    const int a = wave & 3, c = wave >> 2;
    const int li = lane & 15, G = lane >> 4, q4 = li >> 2, p4 = li & 3, hh = lane >> 5, r = lane & 31;
    const MXL unsigned char* viA = lds + OP_VI + (4 * hh + q4) * VI_PITCH + (32 * a + 16 * (G & 1) + 4 * p4) * 2;
    MXL float* part = (MXL float*)(lds + OP_PART);
    for (int it = 0; it < 16; ++it) {
        const int uid = bx * 16 + it, chain = uid >> 5, n = uid & 31, grp = chain >> 6, b = (chain >> 2) & 15, h = chain & 3;
        const int qoff = grp ? 1536 + 64 * h : 64 * h, koff = grp ? 1792 + 64 * h : 256 + 64 * h, voff = (grp ? 2048 : 512) + 128 * h, goff = (grp ? 2560 : 1024) + 128 * h;
        const float lg = __logf(1.0f - __builtin_amdgcn_exp2f(-5.0f - (float)h));
        const size_t row0 = (size_t)b * SEQ + n * 64;
        { const u32x4 qraw = *(const u32x4*)(Z + (row0 + tj) * ZW + qoff + 8 * ts), kraw = *(const u32x4*)(Z + (row0 + tj) * ZW + koff + 8 * ts);
          const u32x4 v0 = *(const u32x4*)(Z + (row0 + tj) * ZW + voff + 16 * ts), v1 = *(const u32x4*)(Z + (row0 + tj) * ZW + voff + 16 * ts + 8);
          f32x4 c0, c1;
          if (grp) { const float* cp = LA + (row0 + tj) * 256 + 64 * h + 8 * ts; c0 = *(const f32x4*)cp; c1 = *(const f32x4*)(cp + 4); }
          else { const float cc = (float)(tj + 1) * lg; c0 = (f32x4){cc, cc, cc, cc}; c1 = c0; }
          float e[8], ei[8];
#pragma unroll
          for (int i = 0; i < 4; ++i) { e[i] = __expf(c0[i]); e[4 + i] = __expf(c1[i]); ei[i] = __expf(-c0[i]); ei[4 + i] = __expf(-c1[i]); }
          u32x4 wq, wk;
          wq.x = cvtpk(lo16(qraw.x) * e[0], hi16(qraw.x) * e[1]); wq.y = cvtpk(lo16(qraw.y) * e[2], hi16(qraw.y) * e[3]); wq.z = cvtpk(lo16(qraw.z) * e[4], hi16(qraw.z) * e[5]); wq.w = cvtpk(lo16(qraw.w) * e[6], hi16(qraw.w) * e[7]);
          wk.x = cvtpk(lo16(kraw.x) * ei[0], hi16(kraw.x) * ei[1]); wk.y = cvtpk(lo16(kraw.y) * ei[2], hi16(kraw.y) * ei[3]); wk.z = cvtpk(lo16(kraw.z) * ei[4], hi16(kraw.z) * ei[5]); wk.w = cvtpk(lo16(kraw.w) * ei[6], hi16(kraw.w) * ei[7]);
          *(MXL u32x4*)(lds + OP_QI + tj * QK_PITCH + 16 * ts) = wq; *(MXL u32x4*)(lds + OP_KI + tj * QK_PITCH + 16 * ts) = wk;
          *(MXL u32x4*)(lds + OP_VI + tj * VI_PITCH + 32 * ts) = v0; *(MXL u32x4*)(lds + OP_VI + tj * VI_PITCH + 32 * ts + 16) = v1; }
        bf16x8 sf[4];
        { const bf16* sp = ST + ((size_t)chain * 32 + n) * 8192 + (size_t)(32 * a + r) * 64 + 8 * hh;
#pragma unroll
          for (int ks = 0; ks < 4; ++ks) sf[ks] = *(const bf16x8*)(sp + 16 * ks); }
        MX_BAR();
        bf16x8 qf[4];
#pragma unroll
        for (int ks = 0; ks < 4; ++ks) qf[ks] = *(const MXL bf16x8*)(lds + OP_QI + (32 * c + r) * QK_PITCH + 32 * ks + 16 * hh);
        f32x16 o = {};
#pragma unroll
        for (int ks = 0; ks < 4; ++ks) o = MX_MFMA(sf[ks], qf[ks], o);
#pragma unroll
        for (int jb = 0; jb < 2; ++jb) if (jb <= c) {
            f32x16 s = {};
#pragma unroll
            for (int ks = 0; ks < 4; ++ks) { const bf16x8 kf = *(const MXL bf16x8*)(lds + OP_KI + (32 * jb + r) * QK_PITCH + 32 * ks + 16 * hh); s = MX_MFMA(kf, qf[ks], s); }
            if (jb == c) {
#pragma unroll
                for (int i = 0; i < 16; ++i) { const int j = 8 * (i >> 2) + 4 * hh + (i & 3); if (j > r) s[i] = 0.f; } }
#pragma unroll
            for (int s2 = 0; s2 < 2; ++s2) { u32x4 w; w.x = cvtpk(s[8 * s2 + 0], s[8 * s2 + 1]); w.y = cvtpk(s[8 * s2 + 2], s[8 * s2 + 3]); w.z = cvtpk(s[8 * s2 + 4], s[8 * s2 + 5]); w.w = cvtpk(s[8 * s2 + 6], s[8 * s2 + 7]);
                const MXL unsigned char* vp = viA + (32 * jb + 16 * s2) * VI_PITCH;
                const bf16x8 vf = cat8(tr4(vp), tr4(vp + 8 * VI_PITCH)); o = MX_MFMA(vf, __builtin_bit_cast(bf16x8, w), o); } }
        float ss = 0.f;
#pragma unroll
        for (int i = 0; i < 16; ++i) ss += o[i] * o[i];
        ss += __shfl_xor(ss, 32);
        if (hh == 0) part[(c * 4 + a) * 32 + r] = ss;
        MX_BAR();
        const float tot = (part[(c * 4 + 0) * 32 + r] + part[(c * 4 + 1) * 32 + r]) + (part[(c * 4 + 2) * 32 + r] + part[(c * 4 + 3) * 32 + r]);
        const float rs = 1.0f / sqrtf(tot * (1.0f / 128.0f) + 1e-6f);
        { const float* ng = (grp ? ng_gla : ng_ret) + h * 128 + 32 * a + 4 * hh; const size_t orow = row0 + 32 * c + r;
          const bf16* gp = Z + orow * ZW + goff + 32 * a + 4 * hh; bf16* op = MO + orow * DM + grp * 512 + h * 128 + 32 * a + 4 * hh;
#pragma unroll
          for (int a4 = 0; a4 < 4; ++a4) { const u32x2 gw = *(const u32x2*)(gp + 8 * a4); const f32x4 gn = *(const f32x4*)(ng + 8 * a4);
              u32x2 w; w.x = cvtpk(o[4 * a4 + 0] * rs * gn[0] * lo16(gw.x), o[4 * a4 + 1] * rs * gn[1] * hi16(gw.x)); w.y = cvtpk(o[4 * a4 + 2] * rs * gn[2] * lo16(gw.y), o[4 * a4 + 3] * rs * gn[3] * hi16(gw.y));
              *(u32x2*)(op + 8 * a4) = w; } }
        MX_BAR();
    }
}
}
constexpr int NWAVES = 8;
constexpr int DM = 1024, NBATCH = 16, SEQ = 2048, MT = NBATCH * SEQ, DFF = 2816, MEML = 256, MR = NBATCH * MEML, INDIM = 3088, NWIN = 3328, ZW = 3072, DEPTH = 2;
constexpr float EPS = 1e-6f;
constexpr int NPHASE = 2 + 16 * DEPTH;
constexpr size_t MiB = 1u << 20;
constexpr size_t WS_CTL = 0, CTL_ZERO_BYTES = 1 * MiB;
constexpr size_t WS_W = 2 * MiB, W_LSTRIDE = 46 * MiB;
constexpr size_t WO_GU1 = 0, WO_D1 = 11 * MiB, WO_WIN = 16 * MiB + 512 * 1024, WO_OUT = 23 * MiB, WO_Q = 25 * MiB, WO_O = 27 * MiB, WO_GU2 = 29 * MiB, WO_D2 = 40 * MiB;
constexpr size_t WS_WK = 94 * MiB, WS_WV = 98 * MiB;
constexpr size_t WS_COS = 102 * MiB, WS_SIN = 106 * MiB;
constexpr size_t WS_RSX = 110 * MiB, WS_RSM = 110 * MiB + 512 * 1024;
constexpr size_t WS_MEMN = 111 * MiB;
constexpr size_t WS_K = 119 * MiB, WS_VT = 135 * MiB;
constexpr size_t WS_EL = 151 * MiB;
constexpr size_t WS_XB = 152 * MiB;
constexpr size_t WS_R1 = 216 * MiB;
constexpr size_t WS_BIG = 280 * MiB;
constexpr size_t WS_LA = WS_BIG + 192 * MiB, WS_END = 512 * MiB;
constexpr int CW_TMO = 0, CW_BAR = 4096;
constexpr int LDS_BYTES = 147456, LDS_MISC = LDS_BYTES - 1024;

#define GAS __attribute__((address_space(1)))
#define LAS __attribute__((address_space(3)))
typedef unsigned short bf16;
typedef unsigned v4u __attribute__((ext_vector_type(4)));
typedef unsigned v2u __attribute__((ext_vector_type(2)));
typedef float f32x4 __attribute__((ext_vector_type(4)));
#define LDS_WAIT() asm volatile("s_waitcnt lgkmcnt(0)" ::: "memory")
#define VM_WAIT() asm volatile("s_waitcnt vmcnt(0)" ::: "memory")
__device__ __forceinline__ unsigned f2bf(float f) { unsigned u = __builtin_bit_cast(unsigned, f); return (u + 0x7fffu + ((u >> 16) & 1u)) >> 16; }
__device__ __forceinline__ unsigned pk2(float lo, float hi) { return f2bf(lo) | (f2bf(hi) << 16); }
__device__ __forceinline__ float bflo(unsigned w) { return __builtin_bit_cast(float, w << 16); }
__device__ __forceinline__ float bfhi(unsigned w) { return __builtin_bit_cast(float, w & 0xffff0000u); }
__device__ __forceinline__ float bf2f(bf16 b) { return __builtin_bit_cast(float, (unsigned)b << 16); }
__device__ __forceinline__ float wave_sum(float v) {
#pragma unroll
    for (int o = 1; o < 64; o <<= 1) v += __shfl_xor(v, o);
    return v;
}

#define XB_TMO      128
#define XB_XCNT(j)  (256  + 64 * (j))
#define XB_XSUB(j)  (1280 + 64 * (j))
#define XB_XGEN(j)  (2304 + 64 * (j))
#define XB_TOP      3328
#define XB_TOPGEN   3392
#define XCD_BAR_WORDS 3456
#define XB_SPIN_CAP (1u << 18)

__device__ __forceinline__ unsigned xb_ld(unsigned* p)              { return __hip_atomic_load(p, __ATOMIC_RELAXED, __HIP_MEMORY_SCOPE_AGENT); }
__device__ __forceinline__ unsigned xb_add(unsigned* p, unsigned v) { return __hip_atomic_fetch_add(p, v, __ATOMIC_RELAXED, __HIP_MEMORY_SCOPE_AGENT); }
__device__ __forceinline__ unsigned xb_xcc_id() { return (unsigned)__builtin_amdgcn_s_getreg((3 << 11) | 20) & 0xFu; }
#define XB_SPIN(cond, bar) do { unsigned _sp = 0; while (cond) { __builtin_amdgcn_s_sleep(1); \
    if ((++_sp & 255u) == 0u) { if (xb_ld(&(bar)[XB_TMO])) break; if (_sp > XB_SPIN_CAP) { atomicAdd(&(bar)[XB_TMO], 1u); break; } } } } while (0)

struct XcdBarrier {
    unsigned* bar; unsigned x;
    volatile LAS unsigned* st;
};

__device__ __forceinline__ XcdBarrier xcd_barrier_post(unsigned* bar, volatile LAS unsigned* st) {
    XcdBarrier b; b.bar = bar; b.x = xb_xcc_id(); b.st = st;
    if (threadIdx.x == 0) (void)xb_add(&bar[XB_XCNT(b.x)], 1u);
    return b;
}
__device__ __forceinline__ void xcd_barrier_complete(unsigned* bar, unsigned x, unsigned& nloc, unsigned& nx) {
    const unsigned G = gridDim.x * gridDim.y * gridDim.z;
    unsigned sum, cnt, mine, sp = 0u;
    for (;;) {
        sum = 0u; cnt = 0u; mine = 0u;
#pragma unroll
        for (unsigned j = 0; j < 16; ++j) { const unsigned c = xb_ld(&bar[XB_XCNT(j)]); sum += c; cnt += (c > 0u) ? 1u : 0u; mine = (j == x) ? c : mine; }
        if (sum == G) break;
        __builtin_amdgcn_s_sleep(1);
        if ((++sp & 255u) == 0u) { if (xb_ld(&bar[XB_TMO])) break; if (sp > XB_SPIN_CAP) { atomicAdd(&bar[XB_TMO], 1u); break; } }
    }
    nloc = mine > 0u ? mine : 1u; nx = cnt > 0u ? cnt : 1u;
}

__device__ __forceinline__ void xcd_barrier(const XcdBarrier& b) {
    asm volatile("s_waitcnt vmcnt(0)" ::: "memory");
    __syncthreads();
    if (threadIdx.x == 0) {
        unsigned* bar = b.bar;
        __builtin_amdgcn_s_waitcnt(0);
        unsigned nloc = b.st[0], nx = b.st[1];
        if (nloc == 0u) { xcd_barrier_complete(bar, b.x, nloc, nx); b.st[0] = nloc; b.st[1] = nx; }
        const unsigned old = xb_add(&bar[XB_XSUB(b.x)], 1u);
        const unsigned gen = old / nloc;
        if (old + 1u == (gen + 1u) * nloc) {
            __builtin_amdgcn_fence(__ATOMIC_RELEASE, "agent");
            asm volatile("s_waitcnt vmcnt(0)" ::: "memory");
            const unsigned og = xb_add(&bar[XB_TOP], 1u);
            const unsigned tg = og / nx;
            if (og + 1u == (tg + 1u) * nx) xb_add(&bar[XB_TOPGEN], 1u);
            else XB_SPIN(xb_ld(&bar[XB_TOPGEN]) == tg, bar);
            __builtin_amdgcn_fence(__ATOMIC_ACQUIRE, "agent");
            xb_add(&bar[XB_XGEN(b.x)], 1u);
            asm volatile("s_waitcnt vmcnt(0)" ::: "memory");
        } else {
            XB_SPIN(xb_ld(&bar[XB_XGEN(b.x)]) == gen, bar);
            __builtin_amdgcn_fence(__ATOMIC_ACQUIRE, "agent");
            asm volatile("s_waitcnt vmcnt(0)" ::: "memory");
        }
    }
    __syncthreads();
}

struct Args { const float* in[27]; float* out; unsigned char* ws; int ph_lo, ph_hi, li, dbl; };

struct Sec { const float* W; const float* gk; bf16* Bt; int ldw, col0, ncols, K, mode, row_off; float scale; };
__device__ __forceinline__ int dst_map(int mode, int j) {
    if (mode == 1) { const int hd = j >> 6, o = j & 63, x2 = o >> 5, oo = o & 31; return (hd << 6) + 8 * (oo >> 2) + 4 * x2 + (oo & 3); }
    if (mode == 2) return 256 * (j >> 7) + (j & 127);
    return j;
}
__device__ __forceinline__ void xpose_item(const Sec& s, LAS float* scr, int item, int lane) {
    const int nblk = s.ncols / 32, kb = item / nblk, nb = item % nblk, k0 = 64 * kb, n0 = 32 * nb;
#pragma unroll 8
    for (int i = 0; i < 32; ++i) { const int kk = 2 * i + (lane >> 5), k = k0 + kk; float w = s.W[(size_t)k * s.ldw + s.col0 + n0 + (lane & 31)]; if (s.gk) w *= s.gk[k]; scr[kk * 33 + (lane & 31)] = w * s.scale; }
    LDS_WAIT(); asm volatile("" ::: "memory");
    const int c = lane & 7;
#pragma unroll
    for (int j = 0; j < 4; ++j) { const int n = (lane >> 3) + 8 * j; const LAS float* p = scr + (8 * c) * 33 + n;
        v4u o; o.x = pk2(p[0 * 33], p[1 * 33]); o.y = pk2(p[2 * 33], p[3 * 33]); o.z = pk2(p[4 * 33], p[5 * 33]); o.w = pk2(p[6 * 33], p[7 * 33]);
        *(GAS v4u*)(s.Bt + (size_t)(s.row_off + dst_map(s.mode, n0 + n)) * s.K + k0 + 8 * c) = o; }
    LDS_WAIT(); asm volatile("" ::: "memory");
}
__device__ __forceinline__ void row_cvt(const float* xrow, bf16* orow, float* rs_out, int lane) {
    const GAS f32x4* xr = (const GAS f32x4*)xrow + lane;
    f32x4 v[4]; float s = 0.f;
#pragma unroll
    for (int j = 0; j < 4; ++j) { v[j] = xr[64 * j]; s += (v[j].x * v[j].x + v[j].y * v[j].y) + (v[j].z * v[j].z + v[j].w * v[j].w); }
    s = wave_sum(s);
    GAS v2u* o8 = (GAS v2u*)orow + lane;
#pragma unroll
    for (int j = 0; j < 4; ++j) { v2u w; w.x = pk2(v[j].x, v[j].y); w.y = pk2(v[j].z, v[j].w); o8[64 * j] = w; }
    if (lane == 0) *rs_out = 1.0f / sqrtf(s * (1.0f / DM) + EPS);
}
__device__ __forceinline__ void thin_row(const float* xin, const bf16* yrow, const float* g, float coef, float* xout, bf16* xb, float* rs_out, int lane) {
    const GAS v2u* yr = (const GAS v2u*)yrow + lane;
    f32x4 y[4]; float s = 0.f;
#pragma unroll
    for (int j = 0; j < 4; ++j) { const v2u w = yr[64 * j]; y[j] = (f32x4){bflo(w.x), bfhi(w.x), bflo(w.y), bfhi(w.y)}; s += (y[j].x * y[j].x + y[j].y * y[j].y) + (y[j].z * y[j].z + y[j].w * y[j].w); }
    const float ry = coef / sqrtf(wave_sum(s) * (1.0f / DM) + EPS);
    const GAS f32x4* xr = (const GAS f32x4*)xin + lane; const GAS f32x4* gr = (const GAS f32x4*)g + lane;
    GAS f32x4* xo = (GAS f32x4*)xout + lane; GAS v2u* o8 = (GAS v2u*)xb + lane; float s2 = 0.f;
#pragma unroll
    for (int j = 0; j < 4; ++j) { const f32x4 xn = xr[64 * j] + y[j] * ry * gr[64 * j]; xo[64 * j] = xn; v2u w; w.x = pk2(xn.x, xn.y); w.y = pk2(xn.z, xn.w); o8[64 * j] = w;
        s2 += (xn.x * xn.x + xn.y * xn.y) + (xn.z * xn.z + xn.w * xn.w); }
    s2 = wave_sum(s2);
    if (lane == 0) *rs_out = 1.0f / sqrtf(s2 * (1.0f / DM) + EPS);
}


#define CAS __attribute__((address_space(4)))
__device__ __forceinline__ int opq(int v) { asm volatile("" : "+s"(v)); return v; }
__device__ __forceinline__ const CAS unsigned char* karg_opaque() { const CAS unsigned char* k = (const CAS unsigned char*)__builtin_amdgcn_kernarg_segment_ptr(); asm volatile("" : "+s"(k)); return k; }
#define PIN(i) (*(const float* const CAS*)(karg_opaque() + 8 * (i)))
#define POUT (*(float* const CAS*)(karg_opaque() + 8 * 27))
#define WSP(off) (*(unsigned char* const CAS*)(karg_opaque() + 8 * 28) + (off))
__global__ void __launch_bounds__(NWAVES * 64, 2) mk_fwd(Args args) {
    extern __shared__ __attribute__((aligned(16))) unsigned char lds_raw[];
    LAS unsigned char* lds = (LAS unsigned char*)lds_raw;
    const int wave = __builtin_amdgcn_readfirstlane(threadIdx.x >> 6);
    const int G = gridDim.x, bx = blockIdx.x;
    const int vcu = (G % 8 == 0) ? (bx % 8) * (G / 8) + bx / 8 : bx;

    volatile LAS unsigned* MISC = (volatile LAS unsigned*)(lds + LDS_MISC);
    if (threadIdx.x < 64) ((LAS unsigned*)(lds + LDS_MISC))[threadIdx.x] = 0u;
    __syncthreads();
    XcdBarrier bar = xcd_barrier_post((unsigned*)WSP(WS_CTL) + CW_BAR + args.li * XCD_BAR_WORDS, MISC + 8);
    const int lo = args.ph_lo, hi = args.ph_hi; constexpr int dbl = MK_DBL;
#define REP(bit) _Pragma("unroll 1") for (int rep_ = 0; rep_ <= ((dbl >> (bit)) & 1); ++rep_)
#define IN(k) (lo <= (k) && (k) < hi)
#define SEAM(k) do { if (IN(k) && IN((k) + 1)) xcd_barrier(bar); } while (0)
    const int gw = vcu * NWAVES + wave, NGW = G * NWAVES, NT = G * NWAVES * 64;
#define LANE_DECL int lane_ = threadIdx.x & 63; asm volatile("" : "+v"(lane_)); const int lane = lane_
#define rsx ((float*)WSP(WS_RSX))
#define rsm ((float*)WSP(WS_RSM))
#define XB ((bf16*)WSP(WS_XB))
#define R1 ((bf16*)WSP(WS_R1))
#define BIG ((bf16*)WSP(WS_BIG))
#define LA ((float*)WSP(WS_LA))
#define MEMN ((bf16*)WSP(WS_MEMN))
#define KB ((bf16*)WSP(WS_K))
#define VT ((bf16*)WSP(WS_VT))
#define cosT ((float*)WSP(WS_COS))
#define sinT ((float*)WSP(WS_SIN))
    if (IN(0)) REP(6) {
        LANE_DECL; const int gtid = (vcu * NWAVES * 64) + (int)threadIdx.x;
        LAS float* scr = (LAS float*)(lds + wave * 16384);
        constexpr int C_GU = 16 * 88, C_D = 44 * 32, C_128 = 16 * 4 * 2, C_256 = 16 * 8 * 2, C_SQ = 16 * 32, PER_L = 6 * C_GU   + 4 * C_128 + 4 * C_256 + 5 * C_SQ;
        static_assert(C_GU == C_D && PER_L == 12544, "item counts");
        for (int it = gw; it < DEPTH * PER_L; it += NGW) {
            const int l = it / PER_L; int r = it % PER_L; Sec s; bool found = false;
            const size_t wl = WS_W + (size_t)l * W_LSTRIDE;
            const float* gF1 = PIN(3) + l * DM; const float* gMix = PIN(8) + l * DM; const float* gXa = PIN(16) + l * DM; const float* gMem = PIN(17) + l * DM; const float* gF2 = PIN(22) + l * DM;
            const float* w_in = PIN(9) + (size_t)l * DM * INDIM; const float* w_kv = PIN(19) + (size_t)l * DM * 2048;
#define SEC(cnt, W_, ldw_, col0_, ncols_, K_, gk_, scale_, Bt_, mode_, roff_) if (!found) { if (r < (cnt)) { s.W = (W_); s.ldw = (ldw_); s.col0 = (col0_); s.ncols = (ncols_); s.K = (K_); s.gk = (gk_); s.scale = (scale_); s.Bt = (bf16*)(Bt_); s.mode = (mode_); s.row_off = (roff_); found = true; } else r -= (cnt); }
            SEC(C_GU, PIN(4) + (size_t)l * DM * DFF, DFF, 0, DFF, DM, gF1, 1.f, WSP(wl + WO_GU1), 2, 0)
            SEC(C_GU, PIN(5) + (size_t)l * DM * DFF, DFF, 0, DFF, DM, gF1, 1.f, WSP(wl + WO_GU1), 2, 128)
            SEC(C_D, PIN(6) + (size_t)l * DFF * DM, DM, 0, DM, DFF, nullptr, 1.f, WSP(wl + WO_D1), 0, 0)
            SEC(C_128, w_in, INDIM, 0, 256, DM, gMix, 1.f, WSP(wl + WO_WIN), 1, 0)
            SEC(C_128, w_in, INDIM, 256, 256, DM, gMix, 0.125f, WSP(wl + WO_WIN), 1, 256)
            SEC(C_256, w_in, INDIM, 512, 512, DM, gMix, 1.f, WSP(wl + WO_WIN), 0, 512)
            SEC(C_256, w_in, INDIM, 1024, 512, DM, gMix, 1.f, WSP(wl + WO_WIN), 0, 1024)
            SEC(C_128, w_in, INDIM, 1536, 256, DM, gMix, 0.125f, WSP(wl + WO_WIN), 0, 1536)
            SEC(C_128, w_in, INDIM, 1792, 256, DM, gMix, 1.f, WSP(wl + WO_WIN), 0, 1792)
            SEC(C_256, w_in, INDIM, 2048, 512, DM, gMix, 1.f, WSP(wl + WO_WIN), 0, 2048)
            SEC(C_256, w_in, INDIM, 2576, 512, DM, gMix, 1.f, WSP(wl + WO_WIN), 0, 2560)
            SEC(C_SQ, PIN(14) + (size_t)l * DM * DM, DM, 0, DM, DM, nullptr, 1.f, WSP(wl + WO_OUT), 0, 0)
            SEC(C_SQ, PIN(18) + (size_t)l * DM * DM, DM, 0, DM, DM, gXa, 0.0625f, WSP(wl + WO_Q), 0, 0)
            SEC(C_SQ, PIN(20) + (size_t)l * DM * DM, DM, 0, DM, DM, nullptr, 1.f, WSP(wl + WO_O), 0, 0)
            SEC(C_SQ, w_kv, 2048, 0, DM, DM, gMem, 1.f, WSP(WS_WK), 0, l * DM)
            SEC(C_SQ, w_kv, 2048, DM, DM, DM, gMem, 1.f, WSP(WS_WV), 0, l * DM)
            SEC(C_GU, PIN(23) + (size_t)l * DM * DFF, DFF, 0, DFF, DM, gF2, 1.f, WSP(wl + WO_GU2), 2, 0)
            SEC(C_GU, PIN(24) + (size_t)l * DM * DFF, DFF, 0, DFF, DM, gF2, 1.f, WSP(wl + WO_GU2), 2, 128)
            SEC(C_D, PIN(25) + (size_t)l * DFF * DM, DM, 0, DM, DFF, nullptr, 1.f, WSP(wl + WO_D2), 0, 0)
#undef SEC
            if (found) xpose_item(s, scr, r, lane);
        }
        for (int idx = gtid; idx < DEPTH * 256 * DM; idx += NT) { const int l = idx >> 18, c = (idx >> 10) & 255, k = idx & 1023;
            const float* wi = PIN(9) + (size_t)l * DM * INDIM + (size_t)k * INDIM + 2560; const float* wa = PIN(10) + l * 16 * 256 + c; float s = 0.f;
#pragma unroll
            for (int r = 0; r < 16; ++r) s += wi[r] * wa[r * 256];
            s *= PIN(8)[l * DM + k];
            ((bf16*)WSP(WS_W + (size_t)l * W_LSTRIDE + WO_WIN))[(size_t)(3072 + c) * DM + k] = (bf16)f2bf(s); }
        { const int* pos = (const int*)PIN(2);
          for (int idx = gtid; idx < MT * 32; idx += NT) { const int m = idx >> 5, f = idx & 31;
            double inv = 1.0; if (f & 1) inv *= 0.7498942093324559; if (f & 2) inv *= 0.5623413251903492; if (f & 4) inv *= 0.316227766016838; if (f & 8) inv *= 0.1; if (f & 16) inv *= 0.01;
            const double ang = (double)pos[m] * inv, j = __builtin_rint(ang * 0.6366197723675814);
            const double rr = __builtin_fma(-j, 6.123233995736766e-17, __builtin_fma(-j, 1.5707963267948966, ang)), z = rr * rr;
            const double sn = rr * (1.0 + z * (-1.0 / 6 + z * (1.0 / 120 + z * (-1.0 / 5040 + z * (1.0 / 362880 + z * (-1.0 / 39916800 + z * (1.0 / 6227020800.0)))))));
            const double cs = 1.0 + z * (-0.5 + z * (1.0 / 24 + z * (-1.0 / 720 + z * (1.0 / 40320 + z * (-1.0 / 3628800 + z * (1.0 / 479001600.0))))));
            const int q = (int)j & 3; const double c = (q == 0) ? cs : (q == 1) ? -sn : (q == 2) ? -cs : sn, s = (q == 0) ? sn : (q == 1) ? cs : (q == 2) ? -sn : -cs;
            cosT[idx] = (float)c; sinT[idx] = (float)s; } }
        for (int m = gw; m < MT; m += NGW) row_cvt(PIN(0) + (size_t)m * DM, XB + (size_t)m * DM, rsx + m, lane);
        for (int m = gw; m < MR; m += NGW) row_cvt(PIN(1) + (size_t)m * DM, MEMN + (size_t)m * DM, rsm + m, lane);
        __syncthreads();
    }
    SEAM(0);
    if (IN(1)) {
        if (bx < 128) { pg8::Gemm g{MEMN, (const bf16*)WSP(WS_WK), MR, 2048, DM}; pg8::StaticOrder S; S.init(MR, 2048, 128, bx);
            pg8::EpiRowScale E{KB, 2048, rsm}; pg8::gemm_phase<pg8::EpiRowScale, pg8::StaticOrder, false, true>(lds, g, S, E); }
        else { pg8::Gemm g{(const bf16*)WSP(WS_WV), MEMN, 2048, MR, DM}; pg8::StaticOrder S; S.init(2048, MR, 128, bx - 128);
            pg8::EpiVT E{VT, MR, rsm}; pg8::gemm_phase<pg8::EpiVT, pg8::StaticOrder, false, true>(lds, g, S, E); }
    }
    SEAM(1);
    for (int l = 0; l < DEPTH; ++l) {
        const int pb = 2 + 16 * l;
        const size_t wl = WS_W + (size_t)l * W_LSTRIDE;
        const float* xin = (l == 0) ? PIN(0) : POUT;
        if (IN(pb + 0)) REP(0) { pg8::Gemm g{XB, (const bf16*)WSP(wl + WO_GU1), MT, 2 * DFF, DM}; pg8::StaticOrder S; S.init(MT, 2 * DFF, opq(G), opq(bx));
            pg8::EpiGU E{BIG, DFF, rsx}; pg8::gemm_phase<pg8::EpiGU, pg8::StaticOrder, true, true>(lds, g, S, E); }
        SEAM(pb + 0);
        if (IN(pb + 1)) REP(1) { pg8::Gemm g{BIG, (const bf16*)WSP(wl + WO_D1), MT, DM, DFF}; pg8::StaticOrder S; S.init(MT, DM, opq(G), opq(bx));
            pg8::EpiPlain E{R1, DM}; pg8::gemm_phase<pg8::EpiPlain, pg8::StaticOrder, true, true>(lds, g, S, E); }
        SEAM(pb + 1);
        if (IN(pb + 2)) { LANE_DECL; const float* gp = PIN(7) + l * DM;
            REP(7) for (int m = gw; m < MT; m += NGW) thin_row((rep_ ? (const float*)POUT : xin) + (size_t)m * DM, R1 + (size_t)m * DM, gp, ((dbl >> 7) & 1) ? 0.5f * 0.5f : 0.5f, POUT + (size_t)m * DM, XB + (size_t)m * DM, rsx + m, lane); }
        SEAM(pb + 2);
        if (IN(pb + 3)) REP(2) { pg8::Gemm g{XB, (const bf16*)WSP(wl + WO_WIN), MT, NWIN, DM}; pg8::StaticOrder S; S.init(MT, NWIN, opq(G), opq(bx));
            pg8::EpiWin E{BIG, LA, rsx, cosT, sinT, PIN(11) + l * 256}; pg8::gemm_phase<pg8::EpiWin, pg8::StaticOrder, true, true>(lds, g, S, E); }
        SEAM(pb + 3);
        if (IN(pb + 4)) { mx::ukv_phase(lds, BIG, LA, R1, (float*)WSP(WS_EL), opq(bx)); }
        SEAM(pb + 4);
        if (IN(pb + 5)) { mx::scan_phase(R1, (const float*)WSP(WS_EL), XB, vcu * NWAVES * 64 + (int)threadIdx.x, NT); }
        SEAM(pb + 5);
        if (IN(pb + 6)) REP(5) { mx::out_phase(lds, BIG, LA, XB, PIN(12) + l * 512, PIN(13) + l * 512, R1, opq(bx)); }
        SEAM(pb + 6);
        if (IN(pb + 7)) REP(3) { pg8::Gemm g{R1, (const bf16*)WSP(wl + WO_OUT), MT, DM, DM}; pg8::StaticOrder S; S.init(MT, DM, opq(G), opq(bx));
            pg8::EpiPlain E{BIG, DM}; pg8::gemm_phase<pg8::EpiPlain, pg8::StaticOrder, true, true>(lds, g, S, E); }
        SEAM(pb + 7);
        if (IN(pb + 8)) { LANE_DECL; const float* gp = PIN(15) + l * DM;
            REP(7) for (int m = gw; m < MT; m += NGW) thin_row(POUT + (size_t)m * DM, BIG + (size_t)m * DM, gp, ((dbl >> 7) & 1) ? 1.0f * 0.5f : 1.0f, POUT + (size_t)m * DM, XB + (size_t)m * DM, rsx + m, lane); }
        SEAM(pb + 8);
        if (IN(pb + 9)) REP(3) { pg8::Gemm g{XB, (const bf16*)WSP(wl + WO_Q), MT, DM, DM}; pg8::StaticOrder S; S.init(MT, DM, opq(G), opq(bx));
            pg8::EpiRowScale E{BIG, DM, rsx}; pg8::gemm_phase<pg8::EpiRowScale, pg8::StaticOrder, true, true>(lds, g, S, E); }
        SEAM(pb + 9);
        if (IN(pb + 10)) REP(4) { mx::xattn_phase(lds, BIG, KB, VT, BIG + (size_t)MT * DM, l, opq(bx)); }
        SEAM(pb + 10);
        if (IN(pb + 11)) REP(3) { pg8::Gemm g{BIG + (size_t)MT * DM, (const bf16*)WSP(wl + WO_O), MT, DM, DM}; pg8::StaticOrder S; S.init(MT, DM, opq(G), opq(bx));
            pg8::EpiPlain E{R1, DM}; pg8::gemm_phase<pg8::EpiPlain, pg8::StaticOrder, true, true>(lds, g, S, E); }
        SEAM(pb + 11);
        if (IN(pb + 12)) { LANE_DECL; const float* gp = PIN(21) + l * DM;
            REP(7) for (int m = gw; m < MT; m += NGW) thin_row(POUT + (size_t)m * DM, R1 + (size_t)m * DM, gp, ((dbl >> 7) & 1) ? 1.0f * 0.5f : 1.0f, POUT + (size_t)m * DM, XB + (size_t)m * DM, rsx + m, lane); }
        SEAM(pb + 12);
        if (IN(pb + 13)) REP(0) { pg8::Gemm g{XB, (const bf16*)WSP(wl + WO_GU2), MT, 2 * DFF, DM}; pg8::StaticOrder S; S.init(MT, 2 * DFF, opq(G), opq(bx));
            pg8::EpiGU E{BIG, DFF, rsx}; pg8::gemm_phase<pg8::EpiGU, pg8::StaticOrder, true, true>(lds, g, S, E); }
        SEAM(pb + 13);
        if (IN(pb + 14)) REP(1) { pg8::Gemm g{BIG, (const bf16*)WSP(wl + WO_D2), MT, DM, DFF}; pg8::StaticOrder S; S.init(MT, DM, opq(G), opq(bx));
            pg8::EpiPlain E{R1, DM}; pg8::gemm_phase<pg8::EpiPlain, pg8::StaticOrder, true, true>(lds, g, S, E); }
        SEAM(pb + 14);
        if (IN(pb + 15)) { LANE_DECL; const float* gp = PIN(26) + l * DM;
            REP(7) for (int m = gw; m < MT; m += NGW) thin_row(POUT + (size_t)m * DM, R1 + (size_t)m * DM, gp, ((dbl >> 7) & 1) ? 0.5f * 0.5f : 0.5f, POUT + (size_t)m * DM, XB + (size_t)m * DM, rsx + m, lane); }
        SEAM(pb + 15);
    }
#undef IN
#undef SEAM
#undef rsx
#undef rsm
#undef XB
#undef R1
#undef BIG
#undef LA
#undef MEMN
#undef KB
#undef VT
#undef cosT
#undef sinT
}

extern "C" void kernel_launch(void* const* d_in, const int* in_sizes, int n_in, void* d_out, int out_size, void* d_ws, size_t ws_size, hipStream_t stream) {
    static int grid = 0;
    if (grid == 0) {
        if (n_in != 27 || out_size != MT * DM || ws_size < WS_END) { fprintf(stderr, "kernel_launch: unexpected shapes (n_in %d out %d ws %zu)\n", n_in, out_size, ws_size); grid = -1; return; }
        if (hipFuncSetAttribute((const void*)mk_fwd, hipFuncAttributeMaxDynamicSharedMemorySize, LDS_BYTES) != hipSuccess) { fprintf(stderr, "kernel_launch: hipFuncSetAttribute failed\n"); grid = -1; return; }
        int dev = 0, cus = 0; (void)hipGetDevice(&dev); (void)hipDeviceGetAttribute(&cus, hipDeviceAttributeMultiprocessorCount, dev);
        int per_cu = 0; (void)hipOccupancyMaxActiveBlocksPerMultiprocessor(&per_cu, (const void*)mk_fwd, NWAVES * 64, LDS_BYTES); (void)hipGetLastError();
        if (cus < 256 || per_cu < 1) fprintf(stderr, "kernel_launch: note: %d CUs, occupancy %d\n", cus, per_cu);
        grid = 256;
    }
    if (grid < 0) return;
    (void)hipMemsetAsync((char*)d_ws + WS_CTL, 0, CTL_ZERO_BYTES, stream);
    Args a{};
    for (int i = 0; i < 27; ++i) a.in[i] = (const float*)d_in[i];
    a.out = (float*)d_out; a.ws = (unsigned char*)d_ws; a.dbl = 0;
    unsigned char* ws = (unsigned char*)d_ws;
    int li = 0;
    auto run = [&](int lo, int hi) { a.ph_lo = lo; a.ph_hi = hi; a.li = li++; hipLaunchKernelGGL(mk_fwd, dim3(grid), dim3(NWAVES * 64), LDS_BYTES, stream, a); };
#if MK_ONE_LAUNCH
    run(0, NPHASE);
#else
    for (int ph = 0; ph < NPHASE; ++ph) run(ph, ph + 1);
#endif
}
```
